# Optimizing an MI355X kernel written in HIP

```python
import math
import jax, jax.numpy as jnp
from jax import lax
import numpy as np

D_MODEL = 1024
BATCH = 32
SEQ = 2048
DEPTH = 4

CHUNK = 64
N_EVEN = (DEPTH + 1) // 2
N_ODD = DEPTH // 2
D_FF = 2816
DEEPNORM_ALPHA = (2 * DEPTH) ** 0.25
DEEPNORM_BETA = (8 * DEPTH) ** -0.25
LN_EPS = 1e-5
NEG_INF = -1e30
ATT_HEAD_DIM = 64
ATT_WIDTH = 3 * D_MODEL // 4
ATT_HEADS = ATT_WIDTH // ATT_HEAD_DIM
N_PREV_CHUNKS = 8
N_BAND = N_PREV_CHUNKS + 1
REL_CLIP = 128
SSM_WIDTH = D_MODEL - ATT_WIDTH
SSM_GROUP = 16
SSM_GROUPS = SSM_WIDTH // SSM_GROUP
SSM_STATE = 64
DT_MIN = 1e-3
DT_MAX = 1e-1
POOL_WINDOWS = (2, 4, 8, 16)
POOL_WIDTH = D_MODEL // 2
POOL_GROUP = POOL_WIDTH // len(POOL_WINDOWS)
SGU_WIDTH = D_MODEL - POOL_WIDTH
SGU_CHUNK = 128
SGU_HEADS = 4
SGU_HEAD_DIM = SGU_WIDTH // SGU_HEADS
AB_IN = 3 * ATT_WIDTH + SSM_WIDTH
CD_IN = POOL_WIDTH + 2 * SGU_WIDTH

kernel_name = 'hybrid_chunk_causal_encoder'


def layer_norm(x, g, b):
    xf = x.astype(jnp.float32)
    mu = jnp.mean(xf, axis=-1, keepdims=True)
    var = jnp.mean(jnp.square(xf - mu), axis=-1, keepdims=True)
    y = (xf - mu) * lax.rsqrt(var + LN_EPS)
    return (y * g.astype(jnp.float32) + b.astype(jnp.float32)).astype(x.dtype)


def swiglu(x, w_gate, w_up, w_down):
    return (jax.nn.silu(x @ w_gate) * (x @ w_up)) @ w_down


def chunk_attention(q, k, v, rel_bias):
    bsz, seq, heads, dh = q.shape
    nc = seq // CHUNK
    q = q.reshape(bsz, nc, CHUNK, heads, dh)
    pad = ((0, 0), (N_PREV_CHUNKS, 0), (0, 0), (0, 0), (0, 0))
    kp = jnp.pad(k.reshape(bsz, nc, CHUNK, heads, dh), pad)
    vp = jnp.pad(v.reshape(bsz, nc, CHUNK, heads, dh), pad)
    scores = jnp.concatenate(
        [jnp.einsum('bnqhd,bnkhd->bnhqk', q, kp[:, j:j + nc],
                    preferred_element_type=jnp.float32) for j in range(N_BAND)],
        axis=-1)
    qi = np.arange(CHUNK)[:, None]
    km = np.arange(N_BAND * CHUNK)[None, :]
    rel = np.clip(N_PREV_CHUNKS * CHUNK + qi - km, -REL_CLIP, REL_CLIP) + REL_CLIP
    bias = rel_bias[:, rel].astype(jnp.float32)
    chunk_ok = (np.arange(nc)[:, None] - N_PREV_CHUNKS + np.arange(N_BAND)[None, :]) >= 0
    valid = jnp.asarray(np.repeat(chunk_ok, CHUNK, axis=1))
    scores = scores * (dh ** -0.5) + bias[None, None]
    scores = jnp.where(valid[None, :, None, None, :], scores, NEG_INF)
    p = jax.nn.softmax(scores, axis=-1).astype(v.dtype)
    out = jnp.einsum('bnhqk,bnkhd->bnqhd', p[..., :CHUNK], vp[:, 0:nc])
    for j in range(1, N_BAND):
        out = out + jnp.einsum('bnhqk,bnkhd->bnqhd',
                               p[..., j * CHUNK:(j + 1) * CHUNK], vp[:, j:j + nc])
    return out.reshape(bsz, seq, heads * dh)


def _complex_linear_combine(e1, e2):
    a1r, a1i, b1r, b1i = e1
    a2r, a2i, b2r, b2i = e2
    ar = a2r * a1r - a2i * a1i
    ai = a2r * a1i + a2i * a1r
    br = a2r * b1r - a2i * b1i + b2r
    bi = a2r * b1i + a2i * b1r + b2i
    return (ar, ai, br, bi)


def s5_mixer(u, a_re, a_im, log_dt, b_re, b_im, c_re, c_im, d, w_glu, b_glu):
    bsz, seq, width = u.shape
    uf = u.astype(jnp.float32)
    ug = uf.reshape(bsz, seq, SSM_GROUPS, SSM_GROUP)
    a_re = a_re.astype(jnp.float32)
    a_im = a_im.astype(jnp.float32)
    dt = jnp.exp(log_dt.astype(jnp.float32))[:, None]
    mag = jnp.exp(dt * a_re)
    ang = dt * a_im
    ab_re = mag * jnp.cos(ang)
    ab_im = mag * jnp.sin(ang)
    den = a_re * a_re + a_im * a_im
    nr = ab_re - 1.0
    ni = ab_im
    coef_re = (nr * a_re + ni * a_im) / den
    coef_im = (ni * a_re - nr * a_im) / den
    b_re = b_re.astype(jnp.float32)
    b_im = b_im.astype(jnp.float32)
    bb_re = coef_re[..., None] * b_re - coef_im[..., None] * b_im
    bb_im = coef_re[..., None] * b_im + coef_im[..., None] * b_re
    bu_re = jnp.einsum('blgh,gph->lbgp', ug, bb_re)
    bu_im = jnp.einsum('blgh,gph->lbgp', ug, bb_im)
    shape_a = (seq, 1, SSM_GROUPS, SSM_STATE)
    at_re = jnp.broadcast_to(ab_re[None, None], shape_a)
    at_im = jnp.broadcast_to(ab_im[None, None], shape_a)
    _, _, s_re, s_im = lax.associative_scan(
        _complex_linear_combine, (at_re, at_im, bu_re, bu_im), axis=0)
    y = (jnp.einsum('lbgp,ghp->blgh', s_re, c_re.astype(jnp.float32))
         - jnp.einsum('lbgp,ghp->blgh', s_im, c_im.astype(jnp.float32)))
    y = y.reshape(bsz, seq, width) + d.astype(jnp.float32) * uf
    g = jax.nn.gelu(y)
    out = g * jax.nn.sigmoid(g @ w_glu.astype(jnp.float32) + b_glu.astype(jnp.float32))
    return out.astype(u.dtype)


def pool_mixer(xc, pool_w, pool_scale):
    bsz, seq, width = xc.shape
    xf = xc.astype(jnp.float32)
    cs = jnp.concatenate([jnp.zeros((bsz, 1, width), jnp.float32),
                          jnp.cumsum(xf, axis=1)], axis=1)
    t = np.arange(seq)
    outs = []
    for g, w in enumerate(POOL_WINDOWS):
        sl = slice(g * POOL_GROUP, (g + 1) * POOL_GROUP)
        lo = np.maximum(t + 1 - w, 0)
        cnt = np.minimum(t + 1, w).astype(np.float32)
        mean = (cs[:, 1:, sl] - cs[:, lo, sl]) / jnp.asarray(cnt)[None, :, None]
        outs.append(mean - xf[..., sl])
    pooled = jnp.stack(outs, axis=2)
    y = jnp.einsum('blgc,gcd->blgd', pooled, pool_w.astype(jnp.float32))
    y = y.reshape(bsz, seq, width) * pool_scale.astype(jnp.float32)
    return y.astype(xc.dtype)


def sgu_mixer(z, ln_g, ln_b, w_s, b_s):
    u, v = jnp.split(z, 2, axis=-1)
    v = layer_norm(v, ln_g, ln_b)
    bsz, seq, width = v.shape
    n = seq // SGU_CHUNK
    v = v.reshape(bsz, n, SGU_CHUNK, SGU_HEADS, SGU_HEAD_DIM)
    mask = jnp.tril(jnp.ones((SGU_CHUNK, SGU_CHUNK), dtype=w_s.dtype))
    sv = jnp.einsum('hts,bnshc->bnthc', w_s * mask[None], v) + b_s.T[None, None, :, :, None]
    return u * sv.reshape(bsz, seq, width)


def setup_inputs(seed: int = 0) -> dict:
    key = jax.random.key(seed)
    ks = iter(jax.random.split(key, 40))

    def nrm(shape, scale):
        return jax.random.normal(next(ks), shape, jnp.float32) * scale

    ne, no = N_EVEN, N_ODD
    x = nrm((BATCH, SEQ, D_MODEL), 1.0)
    ln_g = 1.0 + nrm((DEPTH, 3, D_MODEL), 0.02)
    ln_b = nrm((DEPTH, 3, D_MODEL), 0.02)
    ffn_w_gate = nrm((DEPTH, 2, D_MODEL, D_FF), D_MODEL ** -0.5)
    ffn_w_up = nrm((DEPTH, 2, D_MODEL, D_FF), D_MODEL ** -0.5)
    ffn_w_down = nrm((DEPTH, 2, D_FF, D_MODEL), D_FF ** -0.5 * DEEPNORM_BETA)
    ab_w_in = nrm((ne, D_MODEL, AB_IN), D_MODEL ** -0.5)
    ab_w_out = nrm((ne, D_MODEL, D_MODEL), D_MODEL ** -0.5 * DEEPNORM_BETA)
    att_rel_bias = nrm((ne, ATT_HEADS, 2 * REL_CLIP + 1), 0.5)
    ssm_shape = (ne, SSM_GROUPS, SSM_STATE)
    ssm_a_re = -0.5 + nrm(ssm_shape, 0.01)
    ssm_a_im = math.pi * jnp.arange(SSM_STATE, dtype=jnp.float32)[None, None, :] + nrm(ssm_shape, 0.01)
    ssm_log_dt = jax.random.uniform(next(ks), (ne, SSM_GROUPS), jnp.float32,
                                    minval=math.log(DT_MIN), maxval=math.log(DT_MAX))
    ssm_b_re = nrm((ne, SSM_GROUPS, SSM_STATE, SSM_GROUP), SSM_GROUP ** -0.5)
    ssm_b_im = nrm((ne, SSM_GROUPS, SSM_STATE, SSM_GROUP), SSM_GROUP ** -0.5)
    ssm_c_re = nrm((ne, SSM_GROUPS, SSM_GROUP, SSM_STATE), SSM_STATE ** -0.5)
    ssm_c_im = nrm((ne, SSM_GROUPS, SSM_GROUP, SSM_STATE), SSM_STATE ** -0.5)
    ssm_d = nrm((ne, SSM_WIDTH), 1.0)
    ssm_w_glu = nrm((ne, SSM_WIDTH, SSM_WIDTH), SSM_WIDTH ** -0.5)
    ssm_b_glu = nrm((ne, SSM_WIDTH), 0.01)
    cd_w_in = nrm((no, D_MODEL, CD_IN), D_MODEL ** -0.5)
    cd_w_out = nrm((no, D_MODEL, D_MODEL), D_MODEL ** -0.5 * DEEPNORM_BETA)
    pool_w = nrm((no, len(POOL_WINDOWS), POOL_GROUP, POOL_GROUP), POOL_GROUP ** -0.5)
    pool_scale = 1.0 + nrm((no, POOL_WIDTH), 0.02)
    sgu_ln_g = 1.0 + nrm((no, SGU_WIDTH), 0.02)
    sgu_ln_b = nrm((no, SGU_WIDTH), 0.02)
    sgu_w_s = nrm((no, SGU_HEADS, SGU_CHUNK, SGU_CHUNK), 0.5 * SGU_CHUNK ** -0.5)
    sgu_b_s = 1.0 + nrm((no, SGU_HEADS, SGU_CHUNK), 0.01)
    return {'x': x, 'ln_g': ln_g, 'ln_b': ln_b,
            'ffn_w_gate': ffn_w_gate, 'ffn_w_up': ffn_w_up, 'ffn_w_down': ffn_w_down,
            'ab_w_in': ab_w_in, 'ab_w_out': ab_w_out, 'att_rel_bias': att_rel_bias,
            'ssm_a_re': ssm_a_re, 'ssm_a_im': ssm_a_im, 'ssm_log_dt': ssm_log_dt,
            'ssm_b_re': ssm_b_re, 'ssm_b_im': ssm_b_im, 'ssm_c_re': ssm_c_re,
            'ssm_c_im': ssm_c_im, 'ssm_d': ssm_d, 'ssm_w_glu': ssm_w_glu,
            'ssm_b_glu': ssm_b_glu, 'cd_w_in': cd_w_in, 'cd_w_out': cd_w_out,
            'pool_w': pool_w, 'pool_scale': pool_scale, 'sgu_ln_g': sgu_ln_g,
            'sgu_ln_b': sgu_ln_b, 'sgu_w_s': sgu_w_s, 'sgu_b_s': sgu_b_s}


def reference(x, ln_g, ln_b, ffn_w_gate, ffn_w_up, ffn_w_down, ab_w_in, ab_w_out,
              att_rel_bias, ssm_a_re, ssm_a_im, ssm_log_dt, ssm_b_re, ssm_b_im,
              ssm_c_re, ssm_c_im, ssm_d, ssm_w_glu, ssm_b_glu, cd_w_in, cd_w_out,
              pool_w, pool_scale, sgu_ln_g, sgu_ln_b, sgu_w_s, sgu_b_s):
    bsz, seq, _ = x.shape
    for l in range(DEPTH):
        x = layer_norm(DEEPNORM_ALPHA * x + 0.5 * swiglu(x, ffn_w_gate[l, 0], ffn_w_up[l, 0],
                                                         ffn_w_down[l, 0]),
                       ln_g[l, 0], ln_b[l, 0])
        i = l // 2
        if l % 2 == 0:
            h = x @ ab_w_in[i]
            hs = (bsz, seq, ATT_HEADS, ATT_HEAD_DIM)
            q = h[..., :ATT_WIDTH].reshape(hs)
            k = h[..., ATT_WIDTH:2 * ATT_WIDTH].reshape(hs)
            v = h[..., 2 * ATT_WIDTH:3 * ATT_WIDTH].reshape(hs)
            us = h[..., 3 * ATT_WIDTH:]
            ya = chunk_attention(q, k, v, att_rel_bias[i])
            yb = s5_mixer(us, ssm_a_re[i], ssm_a_im[i], ssm_log_dt[i], ssm_b_re[i],
                          ssm_b_im[i], ssm_c_re[i], ssm_c_im[i], ssm_d[i],
                          ssm_w_glu[i], ssm_b_glu[i])
            mix = jnp.concatenate([ya, yb], axis=-1) @ ab_w_out[i]
        else:
            h = x @ cd_w_in[i]
            yc = pool_mixer(h[..., :POOL_WIDTH], pool_w[i], pool_scale[i])
            yd = sgu_mixer(jax.nn.gelu(h[..., POOL_WIDTH:]), sgu_ln_g[i], sgu_ln_b[i],
                           sgu_w_s[i], sgu_b_s[i])
            mix = jnp.concatenate([yc, yd], axis=-1) @ cd_w_out[i]
        x = layer_norm(DEEPNORM_ALPHA * x + mix, ln_g[l, 1], ln_b[l, 1])
        x = layer_norm(DEEPNORM_ALPHA * x + 0.5 * swiglu(x, ffn_w_gate[l, 1], ffn_w_up[l, 1],
                                                         ffn_w_down[l, 1]),
                       ln_g[l, 2], ln_b[l, 2])
    return x
```

```cpp
#include <hip/hip_runtime.h>
#include <hip/hip_cooperative_groups.h>
#include <cstdio>
#include <cstdint>
namespace cg = cooperative_groups;

#define LAS __attribute__((address_space(3)))
typedef unsigned short u16;
typedef _Float16 half8 __attribute__((ext_vector_type(8)));
typedef _Float16 half4 __attribute__((ext_vector_type(4)));
typedef _Float16 half2 __attribute__((ext_vector_type(2)));
typedef float f32x4 __attribute__((ext_vector_type(4)));
typedef float f32x2 __attribute__((ext_vector_type(2)));
typedef unsigned u32x4 __attribute__((ext_vector_type(4)));
typedef unsigned u32x2 __attribute__((ext_vector_type(2)));

constexpr int DM = 1024, BATCH = 32, SEQ = 2048, DEPTH = 4, MTOK = BATCH * SEQ, DFF = 2816;
constexpr int NGU = 2 * DFF;
constexpr int AB_IN = 2560, CD_IN = 1536;
constexpr float ALPHA = 1.681792830507429f;
constexpr float LN_EPS = 1e-5f;
constexpr float LOG2E = 1.4426950408889634f;

constexpr size_t MiB = 1u << 20;
constexpr size_t WS_X = 0;
constexpr size_t WS_H = 128 * MiB;
constexpr size_t WS_Q = WS_H, WS_K = WS_H + 96 * MiB, WS_VT = WS_H + 192 * MiB, WS_U = WS_H + 288 * MiB;
constexpr size_t WS_HCD = WS_H;
constexpr size_t WS_CAT = 480 * MiB;
constexpr size_t WS_G = 608 * MiB;
constexpr size_t WS_E = 640 * MiB;
constexpr size_t WS_WS16 = 648 * MiB;
constexpr size_t WS_SSMT = 649 * MiB;
constexpr size_t WS_W = 650 * MiB;
constexpr size_t W_GU = 0;
constexpr size_t W_D = W_GU + (size_t)8 * NGU * DM;
constexpr size_t W_ABIN = W_D + (size_t)8 * DM * DFF;
constexpr size_t W_ABOUT = W_ABIN + (size_t)2 * AB_IN * DM;
constexpr size_t W_CDIN = W_ABOUT + (size_t)2 * DM * DM;
constexpr size_t W_CDOUT = W_CDIN + (size_t)2 * CD_IN * DM;
constexpr size_t W_GLU = W_CDOUT + (size_t)2 * DM * DM;
constexpr size_t W_END = W_GLU + (size_t)2 * 256 * 256;
constexpr size_t WS_END = WS_W + W_END * 2;
static_assert(WS_END <= 1024 * MiB, "workspace map");

constexpr int LDS_BYTES = 131072 + 1024;

__device__ __forceinline__ unsigned pkh(float a, float b) { half2 v = {(_Float16)a, (_Float16)b}; return __builtin_bit_cast(unsigned, v); }
__device__ __forceinline__ float h2f(u16 b) { return (float)__builtin_bit_cast(_Float16, b); }
__device__ __forceinline__ u16 f2h(float f) { return __builtin_bit_cast(u16, (_Float16)f); }
__device__ __forceinline__ float wave_sum(float v) {
#pragma unroll
    for (int o = 1; o < 64; o <<= 1) v += __shfl_xor(v, o);
    return v;
}
__device__ __forceinline__ float sigmoid_f(float x) { return __builtin_amdgcn_rcpf(1.0f + __builtin_amdgcn_exp2f(-x * LOG2E)); }
__device__ __forceinline__ float gelu_tanh(float x) { const float u = 1.5957691216057308f * x * (1.0f + 0.044715f * x * x); return x * sigmoid_f(u); }
#define LDS_WAIT() asm volatile("s_waitcnt lgkmcnt(0)" ::: "memory")
__device__ __forceinline__ int fresh_lane() { int l; asm volatile("v_mbcnt_lo_u32_b32 %0, -1, 0\n\tv_mbcnt_hi_u32_b32 %0, -1, %0" : "=v"(l)); return l; }
#define THREAD_VARS const int lane = fresh_lane(), wave = wave0, tid = wave * 64 + lane; const int gw = bid * 8 + wave, NGW = G * 8; const size_t gtid = (size_t)bid * 512 + tid, NT = (size_t)G * 512; (void)lane; (void)gw; (void)NGW; (void)gtid; (void)NT;

namespace pg8 {
constexpr int BM = 256, BK = 64, HALF = 128, HTB = HALF * BK * 2, STAGE_BYTES = 8 * HTB, NXCD = 8, WGM = 8;
__device__ __forceinline__ int lds_byte(int r, int c) { const int st = (r >> 4) * 2 + (c >> 5), rr = r & 15, cc = c & 31, ob = rr * 64 + cc * 2; return st * 1024 + (ob ^ (((ob >> 9) & 1) << 5)); }
__device__ __forceinline__ void stage_rc(int b, int& R, int& C) { const int st = b / 1024, sb = b % 1024, swz = sb ^ (((sb >> 9) & 1) << 5); R = (st >> 1) * 16 + swz / 64; C = (st & 1) * 32 + (swz % 64) / 2; }
__device__ __forceinline__ int perm32(int rho) { const int n = rho >> 4, i = rho & 15; return 8 * (i >> 2) + 4 * n + (i & 3); }

struct Unit { int pm, pn; };
struct Gemm { const u16* A; const u16* Bt; int M, N, K; };
struct StaticOrder {
    int nM, nN, nwg, G, c;
    __device__ void init(int M, int N, int G_, int c_) { nM = M / BM; nN = N / BM; nwg = nM * nN; G = G_; c = c_; }
    __device__ bool next(int i, Unit& u) const {
        const long L = (long)i * G + c; if (L >= nwg) return false;
        int wgid = (int)L; { const int q = nwg / NXCD, r = nwg % NXCD, xcd = wgid % NXCD, off = wgid / NXCD; wgid = (xcd < r ? xcd * (q + 1) : r * (q + 1) + (xcd - r) * q) + off; }
        const int nig = WGM * nN, gid = wgid / nig, fm = gid * WGM, gsz = (nM - fm) < WGM ? (nM - fm) : WGM;
        u.pm = fm + ((wgid % nig) % gsz); u.pn = (wgid % nig) / gsz; return true;
    }
};


struct EpiSwiGLU {
    static constexpr bool PERM = true;
    u16* H;
    __device__ __forceinline__ void operator()(const f32x4 (&acc)[2][2][4][2], const Unit& u, int wr, int wc, int fr, int fq) const {
        const int row0 = u.pm * BM + wr * 64 + fr; const int col0 = u.pn * HALF + wc * 32 + 8 * fq;
#pragma unroll
        for (int ai = 0; ai < 2; ++ai)
#pragma unroll
            for (int m = 0; m < 4; ++m) {
                u16* rowp = H + (size_t)(row0 + ai * HALF + m * 16) * DFF + col0;
                float o[8];
#pragma unroll
                for (int n = 0; n < 2; ++n)
#pragma unroll
                    for (int j = 0; j < 4; ++j) { const float g = acc[ai][0][m][n][j], up = acc[ai][1][m][n][j]; o[n * 4 + j] = g * sigmoid_f(g) * up; }
                u32x4 w; w.x = pkh(o[0], o[1]); w.y = pkh(o[2], o[3]); w.z = pkh(o[4], o[5]); w.w = pkh(o[6], o[7]);
                *(u32x4*)rowp = w;
            }
    }
};
struct EpiResid {
    static constexpr bool PERM = false;
    const u16* X; float* Y; float s;
    __device__ __forceinline__ void operator()(const f32x4 (&acc)[2][2][4][2], const Unit& u, int wr, int wc, int fr, int fq) const {
        const int row0 = u.pm * BM + wr * 64 + fr; const int col0 = u.pn * BM + wc * 32 + 4 * fq;
#pragma unroll
        for (int ai = 0; ai < 2; ++ai)
#pragma unroll
            for (int m = 0; m < 4; ++m) {
                const size_t off = (size_t)(row0 + ai * HALF + m * 16) * DM + col0;
#pragma unroll
                for (int bj = 0; bj < 2; ++bj)
#pragma unroll
                    for (int n = 0; n < 2; ++n) {
                        const half4 xv = *(const half4*)(X + off + bj * HALF + n * 16);
                        const f32x4 a = acc[ai][bj][m][n];
                        f32x4 o; o.x = ALPHA * (float)xv.x + s * a.x; o.y = ALPHA * (float)xv.y + s * a.y; o.z = ALPHA * (float)xv.z + s * a.z; o.w = ALPHA * (float)xv.w + s * a.w;
                        *(f32x4*)(Y + off + bj * HALF + n * 16) = o;
                    }
            }
    }
};
struct EpiInAB {
    static constexpr bool PERM = true;
    u16* Q; u16* Kb; u16* VT; float* U;
    __device__ __forceinline__ void operator()(const f32x4 (&acc)[2][2][4][2], const Unit& u, int wr, int wc, int fr, int fq) const {
        const int row0 = u.pm * BM + wr * 64 + fr; const int pn = u.pn;
#pragma unroll
        for (int ai = 0; ai < 2; ++ai)
#pragma unroll
            for (int m = 0; m < 4; ++m) {
                const int row = row0 + ai * HALF + m * 16;
#pragma unroll
                for (int bj = 0; bj < 2; ++bj) {
                    const f32x4 v0 = acc[ai][bj][m][0], v1 = acc[ai][bj][m][1];
                    const int cl = bj * HALF + wc * 32 + 8 * fq;
                    if (pn < 6) {
                        const float sc = pn < 3 ? 0.125f : 1.0f;
                        u16* dst = (pn < 3 ? Q + (size_t)row * 768 + pn * 256 : Kb + (size_t)row * 768 + (pn - 3) * 256) + cl;
                        u32x4 w; w.x = pkh(v0.x * sc, v0.y * sc); w.y = pkh(v0.z * sc, v0.w * sc); w.z = pkh(v1.x * sc, v1.y * sc); w.w = pkh(v1.z * sc, v1.w * sc);
                        *(u32x4*)dst = w;
                    } else if (pn < 9) {
                        const int cv = (pn - 6) * 256 + cl, h = cv >> 6, d = cv & 63;
                        const int b = row >> 11, t = row & 2047, ch = t >> 6, tk = t & 63;
                        u16* dst = VT + ((((size_t)(b * 12 + h) * 32 + ch) * 64 + d) * 64) + tk;
                        dst[0 * 64] = f2h(v0.x); dst[1 * 64] = f2h(v0.y); dst[2 * 64] = f2h(v0.z); dst[3 * 64] = f2h(v0.w);
                        dst[4 * 64] = f2h(v1.x); dst[5 * 64] = f2h(v1.y); dst[6 * 64] = f2h(v1.z); dst[7 * 64] = f2h(v1.w);
                    } else {
                        float* dst = U + (size_t)row * 256 + cl;
                        *(f32x4*)dst = v0; *(f32x4*)(dst + 4) = v1;
                    }
                    asm volatile("" ::: "memory");
                }
            }
    }
};
struct EpiInCD {
    static constexpr bool PERM = true;
    u16* O;
    __device__ __forceinline__ void operator()(const f32x4 (&acc)[2][2][4][2], const Unit& u, int wr, int wc, int fr, int fq) const {
        const int row0 = u.pm * BM + wr * 64 + fr; const int col0 = u.pn * BM + wc * 32 + 8 * fq; const bool act = u.pn >= 2;
#pragma unroll
        for (int ai = 0; ai < 2; ++ai)
#pragma unroll
            for (int m = 0; m < 4; ++m) {
                u16* rowp = O + (size_t)(row0 + ai * HALF + m * 16) * CD_IN + col0;
#pragma unroll
                for (int bj = 0; bj < 2; ++bj) {
                    f32x4 v0 = acc[ai][bj][m][0], v1 = acc[ai][bj][m][1];
                    if (act) { v0.x = gelu_tanh(v0.x); v0.y = gelu_tanh(v0.y); v0.z = gelu_tanh(v0.z); v0.w = gelu_tanh(v0.w);
                               v1.x = gelu_tanh(v1.x); v1.y = gelu_tanh(v1.y); v1.z = gelu_tanh(v1.z); v1.w = gelu_tanh(v1.w); }
                    u32x4 w; w.x = pkh(v0.x, v0.y); w.y = pkh(v0.z, v0.w); w.z = pkh(v1.x, v1.y); w.w = pkh(v1.z, v1.w);
                    *(u32x4*)(rowp + bj * HALF) = w;
                    asm volatile("" ::: "memory");
                }
            }
    }
};
struct EpiGLU {
    static constexpr bool PERM = true;
    const u16* G; const float* bias; u16* CAT;
    __device__ __forceinline__ void operator()(const f32x4 (&acc)[2][2][4][2], const Unit& u, int wr, int wc, int fr, int fq) const {
        const int row0 = u.pm * BM + wr * 64 + fr; const int col0 = wc * 32 + 8 * fq;
#pragma unroll
        for (int ai = 0; ai < 2; ++ai)
#pragma unroll
            for (int m = 0; m < 4; ++m) {
                const int row = row0 + ai * HALF + m * 16;
#pragma unroll
                for (int bj = 0; bj < 2; ++bj) {
                    const int col = col0 + bj * HALF;
                    const half8 g = *(const half8*)(G + (size_t)row * 256 + col);
                    const f32x4 b0 = *(const f32x4*)(bias + col), b1 = *(const f32x4*)(bias + col + 4);
                    const f32x4 v0 = acc[ai][bj][m][0] + b0, v1 = acc[ai][bj][m][1] + b1;
                    float o[8];
                    o[0] = (float)g[0] * sigmoid_f(v0.x); o[1] = (float)g[1] * sigmoid_f(v0.y); o[2] = (float)g[2] * sigmoid_f(v0.z); o[3] = (float)g[3] * sigmoid_f(v0.w);
                    o[4] = (float)g[4] * sigmoid_f(v1.x); o[5] = (float)g[5] * sigmoid_f(v1.y); o[6] = (float)g[6] * sigmoid_f(v1.z); o[7] = (float)g[7] * sigmoid_f(v1.w);
                    u32x4 w; w.x = pkh(o[0], o[1]); w.y = pkh(o[2], o[3]); w.z = pkh(o[4], o[5]); w.w = pkh(o[6], o[7]);
                    *(u32x4*)(CAT + (size_t)row * DM + 768 + col) = w;
                    asm volatile("" ::: "memory");
                }
            }
    }
};

template <class Epi>
__device__ __forceinline__ void gemm_phase(LAS unsigned char* lds, const Gemm g, const StaticOrder& S, const Epi& E, const int wid) {
    const int lane = fresh_lane(), tid = wid * 64 + lane, wr = wid >> 2, wc = wid & 3, fr = lane & 15, fq = lane >> 4;
    const int K = g.K, nt = K / BK;
    unsigned voffA[2], voffB[2];
#pragma unroll
    for (int i = 0; i < 2; ++i) { int R, C; stage_rc(tid * 16 + i * 8192, R, C); const int Rb = Epi::PERM ? ((R & ~31) + perm32(R & 31)) : R;
        voffA[i] = (unsigned)(R * K + C) * 2u; voffB[i] = (unsigned)(Rb * K + C) * 2u; }
    const size_t kstep = (size_t)(BK * 2);
    const size_t hstep = (size_t)HALF * K * 2;
    const size_t tstep = 2 * hstep;
    const unsigned lbase = (unsigned)(size_t)lds + (unsigned)wid * 1024u;
    const int aoff = lds_byte(wr * 64 + fr, fq * 8), boff = lds_byte(wc * 32 + fr, fq * 8);
#define PG8_SA(b, h) (((b) * 2 + (h)) * HTB)
#define PG8_SB(b, h) ((4 + (b) * 2 + (h)) * HTB)
#define PG8_STAGE1(bufoff, gbase, voff, I) asm volatile("s_add_u32 m0, %1, %3\n\ts_nop 0\n\tglobal_load_lds_dwordx4 %0, %2" \
            :: "v"((voff)[I]), "s"(lbase), "s"((const void*)(gbase)), "i"((bufoff) + (I) * 8192) : "memory", "m0", "scc")
#define PG8_STAGE(bufoff, gbase, voff) do { PG8_STAGE1(bufoff, gbase, voff, 0); PG8_STAGE1(bufoff, gbase, voff, 1); } while (0)
#define PG8_LDA(dst, b, h) do { _Pragma("unroll") for (int m = 0; m < 4; ++m) _Pragma("unroll") for (int k = 0; k < 2; ++k) dst[m][k] = *(const LAS half8*)(lds + PG8_SA(b, h) + aoff + m * 2048 + k * 1024); } while (0)
#define PG8_LDB(dst, b, h) do { _Pragma("unroll") for (int n = 0; n < 2; ++n) _Pragma("unroll") for (int k = 0; k < 2; ++k) dst[n][k] = *(const LAS half8*)(lds + PG8_SB(b, h) + boff + n * 2048 + k * 1024); } while (0)
#define PG8_MMA(ai, bj, At, Bt) do { __builtin_amdgcn_s_setprio(1); _Pragma("unroll") for (int m = 0; m < 4; ++m) _Pragma("unroll") for (int n = 0; n < 2; ++n) _Pragma("unroll") for (int k = 0; k < 2; ++k) \
        acc[ai][bj][m][n] = __builtin_amdgcn_mfma_f32_16x16x32_f16(Bt[n][k], At[m][k], acc[ai][bj][m][n], 0, 0, 0); __builtin_amdgcn_s_setprio(0); } while (0)
#define PG8_WAIT_V(n) asm volatile("s_waitcnt vmcnt(" #n ")" ::: "memory")
#define PG8_WAIT_L(n) asm volatile("s_waitcnt lgkmcnt(" #n ")" ::: "memory")
#define PG8_BAR __builtin_amdgcn_s_barrier()
#define PG8_SCHED __builtin_amdgcn_sched_barrier(0)
    Unit cur, nxt; int ui = 0;
    if (!S.next(0, cur)) return;
    f32x4 acc[2][2][4][2];
#pragma unroll
    for (int a = 0; a < 2; ++a)
#pragma unroll
        for (int b = 0; b < 2; ++b)
#pragma unroll
            for (int m = 0; m < 4; ++m)
#pragma unroll
                for (int n = 0; n < 2; ++n) acc[a][b][m][n] = (f32x4){0.f, 0.f, 0.f, 0.f};
    half8 At[4][2], B0[2][2], B1[2][2];
    const char* cA = (const char*)g.A + (size_t)cur.pm * tstep; const char* cB = (const char*)g.Bt + (size_t)cur.pn * tstep;
    PG8_STAGE(PG8_SB(0, 0), cB, voffB); PG8_STAGE(PG8_SB(0, 1), cB + hstep, voffB); PG8_STAGE(PG8_SA(0, 0), cA, voffA); PG8_STAGE(PG8_SA(0, 1), cA + hstep, voffA);
    if (wr == 1) PG8_BAR;
    PG8_WAIT_V(2); PG8_BAR;
    PG8_STAGE(PG8_SB(1, 0), cB + kstep, voffB); PG8_STAGE(PG8_SA(1, 0), cA + kstep, voffA); PG8_STAGE(PG8_SB(1, 1), cB + hstep + kstep, voffB);
    PG8_WAIT_V(6); PG8_BAR;
    for (;;) {
        const bool has_next = S.next(ui + 1, nxt);
        const char* nA = has_next ? (const char*)g.A + (size_t)nxt.pm * tstep : cA; const char* nB = has_next ? (const char*)g.Bt + (size_t)nxt.pn * tstep : cB;
        for (int t = 0; t < nt; t += 2) {
            const bool last = (t == nt - 2);
            const char* a1 = cA + (size_t)(t + 1) * kstep;
            const char* a2 = last ? nA : cA + (size_t)(t + 2) * kstep; const char* b2 = last ? nB : cB + (size_t)(t + 2) * kstep;
            const char* a3 = a2 + kstep; const char* b3 = b2 + kstep;
            PG8_LDB(B0, 0, 0); PG8_LDB(B1, 0, 1); PG8_SCHED; PG8_LDA(At, 0, 0); PG8_STAGE(PG8_SA(1, 1), a1 + hstep, voffA);
            PG8_WAIT_V(8); PG8_WAIT_L(0); PG8_BAR; PG8_MMA(0, 0, At, B0); PG8_MMA(0, 1, At, B1); PG8_BAR; PG8_SCHED;
            PG8_LDA(At, 0, 1); PG8_STAGE(PG8_SB(0, 0), b2, voffB); PG8_STAGE(PG8_SB(0, 1), b2 + hstep, voffB); PG8_STAGE(PG8_SA(0, 0), a2, voffA);
            PG8_WAIT_V(8); PG8_WAIT_L(0); PG8_BAR; PG8_MMA(1, 0, At, B0); PG8_MMA(1, 1, At, B1); PG8_BAR; PG8_SCHED;
            PG8_LDB(B0, 1, 0); PG8_LDB(B1, 1, 1); PG8_SCHED; PG8_LDA(At, 1, 0); PG8_STAGE(PG8_SA(0, 1), a2 + hstep, voffA);
            PG8_WAIT_V(8); PG8_WAIT_L(0); PG8_BAR; PG8_MMA(0, 0, At, B0); PG8_MMA(0, 1, At, B1); PG8_BAR; PG8_SCHED;
            PG8_LDA(At, 1, 1); PG8_STAGE(PG8_SB(1, 0), b3, voffB); PG8_STAGE(PG8_SB(1, 1), b3 + hstep, voffB); PG8_STAGE(PG8_SA(1, 0), a3, voffA);
            PG8_WAIT_V(8); PG8_WAIT_L(0); PG8_BAR; PG8_MMA(1, 0, At, B0); PG8_MMA(1, 1, At, B1); PG8_BAR; PG8_SCHED;
        }
        if (wr == 0) PG8_BAR;
        E(acc, cur, wr, wc, fr, fq);
        if (!has_next) break;
#pragma unroll
        for (int a = 0; a < 2; ++a)
#pragma unroll
            for (int b = 0; b < 2; ++b)
#pragma unroll
                for (int m = 0; m < 4; ++m)
#pragma unroll
                    for (int n = 0; n < 2; ++n) acc[a][b][m][n] = (f32x4){0.f, 0.f, 0.f, 0.f};
        cur = nxt; cA = nA; cB = nB; ++ui;
        if (wr == 1) PG8_BAR;
    }
    PG8_WAIT_V(0);
    PG8_BAR;
#undef PG8_SA
#undef PG8_SB
#undef PG8_STAGE
#undef PG8_STAGE1
#undef PG8_LDA
#undef PG8_LDB
#undef PG8_MMA
#undef PG8_WAIT_V
#undef PG8_WAIT_L
#undef PG8_BAR
#undef PG8_SCHED
}
}

__device__ __forceinline__ void conv_items(const float* W, int K, int N, u16* WT, int ldd, int coff, int mode, LAS float* scr, int lane, int gw, int NGW, int& base) {
    const int nblk = N / 32, nitems = (K / 64) * nblk;
    const int first = (gw - (base % NGW) + NGW) % NGW;
    for (int it = first; it < nitems; it += NGW) {
        const int kb = it / nblk, nb = it % nblk, k0 = 64 * kb, n0 = 32 * nb;
        int drow0 = n0; if (mode) drow0 = (n0 >> 7) * 256 + (n0 & 127) + (mode == 2 ? 128 : 0);
#pragma unroll 8
        for (int i = 0; i < 32; ++i) { const int kk = 2 * i + (lane >> 5); scr[kk * 33 + (lane & 31)] = W[(size_t)(k0 + kk) * N + n0 + (lane & 31)]; }
        LDS_WAIT();
        const int c = lane & 7;
#pragma unroll
        for (int j = 0; j < 4; ++j) { const int n = (lane >> 3) + 8 * j; const LAS float* s = scr + (8 * c) * 33 + n;
            u32x4 o; o.x = pkh(s[0 * 33], s[1 * 33]); o.y = pkh(s[2 * 33], s[3 * 33]); o.z = pkh(s[4 * 33], s[5 * 33]); o.w = pkh(s[6 * 33], s[7 * 33]);
            *(u32x4*)(WT + (size_t)(drow0 + n) * ldd + coff + k0 + 8 * c) = o; }
        LDS_WAIT();
    }
    base += nitems;
}

struct Params { const float* in[27]; float* out; unsigned char* ws; };

__device__ __forceinline__ void attn_task(const u16* Q, const u16* Kb, const u16* VT, const float* rb, u16* cat, int b, int h, int c, int qq, int lane) {
    const int fr = lane & 15, fq = lane >> 4;
    const size_t qtok = (size_t)b * SEQ + c * 64 + qq * 16 + fr;
    half8 qf[2];
#pragma unroll
    for (int s = 0; s < 2; ++s) qf[s] = *(const half8*)(Q + qtok * 768 + h * 64 + s * 32 + fq * 8);
    const float b256 = rb[256];
    const int qi = qq * 16 + fr;
    float m = -1e30f, l = 0.f;
    f32x4 O[4];
#pragma unroll
    for (int dt = 0; dt < 4; ++dt) O[dt] = (f32x4){0.f, 0.f, 0.f, 0.f};
    for (int half = 0; half < 2; ++half) {
        f32x4 S[18];
#pragma unroll
        for (int k9 = 0; k9 < 9; ++k9) {
            const int ks = half * 9 + k9;
            const int cc = c - 8 + (ks >> 1);
            if (cc >= 0) {
                const size_t tokb = (size_t)b * SEQ + cc * 64 + (ks & 1) * 32;
#pragma unroll
                for (int tt = 0; tt < 2; ++tt) {
                    const int krow = (fr >> 2) * 8 + tt * 4 + (fr & 3);
                    const u16* kp = Kb + (tokb + krow) * 768 + h * 64 + fq * 8;
                    const half8 k0 = *(const half8*)kp, k1 = *(const half8*)(kp + 32);
                    f32x4 a = {0.f, 0.f, 0.f, 0.f};
                    a = __builtin_amdgcn_mfma_f32_16x16x32_f16(k0, qf[0], a, 0, 0, 0);
                    a = __builtin_amdgcn_mfma_f32_16x16x32_f16(k1, qf[1], a, 0, 0, 0);
                    if (ks >= 12) {
#pragma unroll
                        for (int j = 0; j < 4; ++j) { const int km = 32 * ks + fq * 8 + tt * 4 + j; int idx = 640 + qi - km; idx = idx > 256 ? 256 : idx; a[j] += rb[idx]; }
                    } else { a += b256; }
                    S[k9 * 2 + tt] = a;
                }
            } else { S[k9 * 2] = (f32x4){-1e30f, -1e30f, -1e30f, -1e30f}; S[k9 * 2 + 1] = S[k9 * 2]; }
            if (k9 & 1) asm volatile("" ::: "memory");
        }
        float mx = m;
#pragma unroll
        for (int i = 0; i < 18; ++i) mx = fmaxf(mx, fmaxf(fmaxf(S[i].x, S[i].y), fmaxf(S[i].z, S[i].w)));
        mx = fmaxf(mx, __shfl_xor(mx, 16)); mx = fmaxf(mx, __shfl_xor(mx, 32));
        const float sc = __builtin_amdgcn_exp2f((m - mx) * LOG2E);
        l *= sc;
#pragma unroll
        for (int dt = 0; dt < 4; ++dt) O[dt] = O[dt] * sc;
        m = mx;
        const float mxl = mx * LOG2E;
#pragma unroll
        for (int k9 = 0; k9 < 9; ++k9) {
            const int ks = half * 9 + k9;
            const int cc = c - 8 + (ks >> 1);
            if (cc >= 0) {
                half8 pf;
#pragma unroll
                for (int tt = 0; tt < 2; ++tt)
#pragma unroll
                    for (int j = 0; j < 4; ++j) { const float pe = __builtin_amdgcn_exp2f(S[2 * k9 + tt][j] * LOG2E - mxl); l += pe; pf[tt * 4 + j] = (_Float16)pe; }
                const u16* vb = VT + ((((size_t)(b * 12 + h) * 32 + cc) * 64 + fr) * 64) + (ks & 1) * 32 + fq * 8;
#pragma unroll
                for (int dt = 0; dt < 4; ++dt) {
                    const half8 vt = *(const half8*)(vb + dt * 16 * 64);
                    O[dt] = __builtin_amdgcn_mfma_f32_16x16x32_f16(vt, pf, O[dt], 0, 0, 0);
                }
            }
            if (k9 & 1) asm volatile("" ::: "memory");
        }
    }
    l += __shfl_xor(l, 16); l += __shfl_xor(l, 32);
    const float inv = 1.0f / l;
#pragma unroll
    for (int dt = 0; dt < 4; ++dt) {
        u32x2 w; w.x = pkh(O[dt].x * inv, O[dt].y * inv); w.y = pkh(O[dt].z * inv, O[dt].w * inv);
        *(u32x2*)(cat + qtok * DM + h * 64 + dt * 16 + fq * 4) = w;
    }
}

struct SsmP { float ar, ai, a64r, a64i; float bbr[16], bbi[16]; };
__device__ __forceinline__ void ssm_build(float* T, const float* a_re, const float* a_im, const float* log_dt, const float* b_re, const float* b_im, int g, int p) {
    const double dt = exp((double)log_dt[g]);
    const double are = (double)a_re[g * 64 + p], aim = (double)a_im[g * 64 + p];
    const double mag = exp(dt * are), ang = dt * aim;
    const double abr = mag * cos(ang), abi = mag * sin(ang);
    const double den = are * are + aim * aim, nr = abr - 1.0, ni = abi;
    const double cr = (nr * are + ni * aim) / den, ci = (ni * are - nr * aim) / den;
    const double m64 = exp(64.0 * dt * are), a64 = 64.0 * ang;
    T[0] = (float)abr; T[1] = (float)abi; T[2] = (float)(m64 * cos(a64)); T[3] = (float)(m64 * sin(a64));
    const float* br = b_re + (size_t)(g * 64 + p) * 16; const float* bi = b_im + (size_t)(g * 64 + p) * 16;
    for (int h = 0; h < 16; ++h) { const double r = br[h], i = bi[h]; T[4 + h] = (float)(cr * r - ci * i); T[20 + h] = (float)(cr * i + ci * r); }
}
__device__ __forceinline__ void ssm_setup(SsmP& P, const float* T) {
    const f32x4 a = *(const f32x4*)T; P.ar = a.x; P.ai = a.y; P.a64r = a.z; P.a64i = a.w;
#pragma unroll
    for (int h4 = 0; h4 < 4; ++h4) {
        const f32x4 r = *(const f32x4*)(T + 4 + 4 * h4), i = *(const f32x4*)(T + 20 + 4 * h4);
#pragma unroll
        for (int e = 0; e < 4; ++e) { P.bbr[4 * h4 + e] = r[e]; P.bbi[4 * h4 + e] = i[e]; }
    }
}
__device__ __forceinline__ void ssm_load_u(const float* U, size_t tok, int g, LAS float* ublk, int lane) {
    const f32x4 v = *(const f32x4*)(U + (tok + (lane >> 2)) * 256 + g * 16 + (lane & 3) * 4);
    *(LAS f32x4*)(ublk + (lane >> 2) * 16 + (lane & 3) * 4) = v;
}
__device__ __forceinline__ void ssm_step(const SsmP& P, const LAS float* ut, float& sr, float& si) {
    float bur = 0.f, bui = 0.f;
#pragma unroll
    for (int h4 = 0; h4 < 4; ++h4) { const f32x4 u = *(const LAS f32x4*)(ut + 4 * h4);
#pragma unroll
        for (int e = 0; e < 4; ++e) { bur += P.bbr[4 * h4 + e] * u[e]; bui += P.bbi[4 * h4 + e] * u[e]; } }
    const float nsr = P.ar * sr - P.ai * si + bur, nsi = P.ar * si + P.ai * sr + bui;
    sr = nsr; si = nsi;
}

typedef const __attribute__((address_space(4))) Params* KP;
#define PHASE_PTRS KP kp = (KP)__builtin_amdgcn_kernarg_segment_ptr(); int G = G0, bid = bid0; asm volatile("" : "+s"(kp), "+s"(G), "+s"(bid)); unsigned char* ws = kp->ws; \
    u16* X = (u16*)(ws + WS_X); u16* H = (u16*)(ws + WS_H); u16* CAT = (u16*)(ws + WS_CAT); u16* GB = (u16*)(ws + WS_G); \
    u16* Qb = (u16*)(ws + WS_Q); u16* Kb = (u16*)(ws + WS_K); u16* VT = (u16*)(ws + WS_VT); float* U = (float*)(ws + WS_U); \
    u16* HCD = (u16*)(ws + WS_HCD); float* E = (float*)(ws + WS_E); u16* WS16 = (u16*)(ws + WS_WS16); u16* W = (u16*)(ws + WS_W); float* SSMT = (float*)(ws + WS_SSMT); \
    float* Y = kp->out; (void)X; (void)H; (void)CAT; (void)GB; (void)Qb; (void)Kb; (void)VT; (void)U; (void)HCD; (void)E; (void)WS16; (void)W; (void)SSMT; (void)Y;
#define PIN(k) ((const float*)kp->in[k])
__global__ void __launch_bounds__(512, 2) fwd_megakernel(Params p) {
    extern __shared__ __attribute__((aligned(16))) unsigned char lds_raw[];
    LAS unsigned char* lds = (LAS unsigned char*)lds_raw;
    cg::grid_group grid = cg::this_grid();
    const int G0 = gridDim.x, bid0 = blockIdx.x;
    const int wave0 = __builtin_amdgcn_readfirstlane((int)threadIdx.x >> 6);

    {
        PHASE_PTRS THREAD_VARS
        LAS float* scr = (LAS float*)(lds + wave * 16384);
        int base = 0;
        for (int ls = 0; ls < 8; ++ls) {
            conv_items(PIN(3) + (size_t)ls * DM * DFF, DM, DFF, W + W_GU + (size_t)ls * NGU * DM, DM, 0, 1, scr, lane, gw, NGW, base);
            conv_items(PIN(4) + (size_t)ls * DM * DFF, DM, DFF, W + W_GU + (size_t)ls * NGU * DM, DM, 0, 2, scr, lane, gw, NGW, base);
            conv_items(PIN(5) + (size_t)ls * DFF * DM, DFF, DM, W + W_D + (size_t)ls * DM * DFF, DFF, 0, 0, scr, lane, gw, NGW, base);
        }
        for (int i = 0; i < 2; ++i) {
            conv_items(PIN(6) + (size_t)i * DM * AB_IN, DM, AB_IN, W + W_ABIN + (size_t)i * AB_IN * DM, DM, 0, 0, scr, lane, gw, NGW, base);
            conv_items(PIN(7) + (size_t)i * DM * DM, DM, DM, W + W_ABOUT + (size_t)i * DM * DM, DM, 0, 0, scr, lane, gw, NGW, base);
            conv_items(PIN(19) + (size_t)i * DM * CD_IN, DM, CD_IN, W + W_CDIN + (size_t)i * CD_IN * DM, DM, 0, 0, scr, lane, gw, NGW, base);
            conv_items(PIN(20) + (size_t)i * DM * DM + (size_t)512 * DM, 512, DM, W + W_CDOUT + (size_t)i * DM * DM, DM, 512, 0, scr, lane, gw, NGW, base);
            conv_items(PIN(17) + (size_t)i * 256 * 256, 256, 256, W + W_GLU + (size_t)i * 256 * 256, 256, 0, 0, scr, lane, gw, NGW, base);
        }
        for (size_t idx = gtid; idx < (size_t)2 * 512 * 1024; idx += NT) {
            const int i = (int)(idx >> 19), r = (int)(idx & 524287), row = r >> 10, n = r & 1023, gq = row >> 7;
            const float* pw = PIN(21) + (size_t)i * 4 * 128 * 128 + (size_t)row * 128;
            const float* sc = PIN(22) + i * 512 + gq * 128;
            const float* wo = PIN(20) + (size_t)i * DM * DM + (size_t)(gq * 128) * DM + n;
            float a = 0.f;
            for (int d = 0; d < 128; ++d) a += pw[d] * sc[d] * wo[(size_t)d * DM];
            W[W_CDOUT + (size_t)i * DM * DM + (size_t)n * DM + row] = f2h(a);
        }
        if (gtid < 2048) { const int i = (int)gtid >> 10, g = ((int)gtid >> 6) & 15, pp = (int)gtid & 63;
            ssm_build(SSMT + gtid * 36, PIN(9) + i * 1024, PIN(10) + i * 1024, PIN(11) + i * 16, PIN(12) + (size_t)i * 16384, PIN(13) + (size_t)i * 16384, g, pp); }
        for (size_t idx = gtid; idx < (size_t)2 * 4 * 128 * 128; idx += NT) {
            const int t = (int)(idx >> 7) & 127, s = (int)idx & 127;
            WS16[idx] = s <= t ? f2h(PIN(25)[idx]) : (u16)0;
        }
        const float* x = PIN(0);
        for (size_t idx = gtid; idx < (size_t)MTOK * DM / 8; idx += NT) {
            const f32x4 a = *(const f32x4*)(x + idx * 8), b = *(const f32x4*)(x + idx * 8 + 4);
            u32x4 w; w.x = pkh(a.x, a.y); w.y = pkh(a.z, a.w); w.z = pkh(b.x, b.y); w.w = pkh(b.z, b.w);
            *(u32x4*)(X + idx * 8) = w;
        }
    }
    grid.sync();

    for (int l = 0; l < DEPTH; ++l) {
        const int li = l >> 1;
        for (int sub = 0; sub < 3; ++sub) {
            int rsel;
            if (sub != 1) {
                const int ls = l * 2 + (sub >> 1);
                { PHASE_PTRS pg8::Gemm g{X, W + W_GU + (size_t)ls * NGU * DM, MTOK, NGU, DM}; pg8::StaticOrder S; S.init(MTOK, NGU, G, bid);
                  pg8::EpiSwiGLU Ep{H};
#ifndef NO_GU
 pg8::gemm_phase<pg8::EpiSwiGLU>(lds, g, S, Ep, wave0);
#endif
 }
                grid.sync();
                rsel = 0;
            } else if ((l & 1) == 0) {
                { PHASE_PTRS pg8::Gemm g{X, W + W_ABIN + (size_t)li * AB_IN * DM, MTOK, AB_IN, DM}; pg8::StaticOrder S; S.init(MTOK, AB_IN, G, bid);
                  pg8::EpiInAB Ep{Qb, Kb, VT, U};
#ifndef NO_INAB
 pg8::gemm_phase<pg8::EpiInAB>(lds, g, S, Ep, wave0);
#endif
 }
                grid.sync();
                {
                PHASE_PTRS THREAD_VARS
                const float* c_re = PIN(14) + (size_t)li * 16384; const float* c_im = PIN(15) + (size_t)li * 16384;
                const float* dsk = PIN(16) + li * 256;
                LAS float* ublk = (LAS float*)(lds + wave * 8192);
                LAS u16* S16 = (LAS u16*)(lds + wave * 8192 + 1024);
#ifndef NO_SSM1
                for (int tk = gw; tk < 16384; tk += NGW) {
                    const int c = tk & 31, g = (tk >> 5) & 15, b = tk >> 9;
                    if (c == 31) continue;
                    SsmP P; ssm_setup(P, SSMT + (size_t)((li * 16 + g) * 64 + lane) * 36);
                    float sr = 0.f, si = 0.f;
                    const size_t tok0 = (size_t)b * SEQ + c * 64;
                    for (int blk = 0; blk < 4; ++blk) {
                        LDS_WAIT();
                        ssm_load_u(U, tok0 + blk * 16, g, ublk, lane);
                        LDS_WAIT();
#pragma unroll
                        for (int t = 0; t < 16; ++t) ssm_step(P, ublk + t * 16, sr, si);
                    }
                    *(f32x2*)(E + ((size_t)((b * 16 + g) * 32 + c) * 64 + lane) * 2) = (f32x2){sr, si};
                }
#endif
#ifndef NO_ATTN
                {
                    const float* relb = PIN(8) + (size_t)li * 12 * 257;
                    for (int bt = bid; bt < 6144; bt += G) {
                        const int cp = bt & 15, bh = bt >> 4, h = bh % 12, b = bh / 12;
                        attn_task(Qb, Kb, VT, relb + h * 257, CAT, b, h, cp * 2 + (wave >> 2), wave & 3, lane);
                    }
                }
#endif
                grid.sync();
#ifndef NO_SSM3
                for (int tk = gw; tk < 16384; tk += NGW) {
                    const int c = tk & 31, g = (tk >> 5) & 15, b = tk >> 9;
                    const int fr = lane & 15, fq = lane >> 4;
                    SsmP P; ssm_setup(P, SSMT + (size_t)((li * 16 + g) * 64 + lane) * 36);
                    half8 cB[4];
#pragma unroll
                    for (int ks = 0; ks < 4; ++ks) {
                        const float* src = (ks < 2 ? c_re : c_im) + (size_t)(g * 16 + fr) * 64 + (ks & 1) * 32 + fq * 8;
                        const f32x4 v0 = *(const f32x4*)src, v1 = *(const f32x4*)(src + 4); const float sg = ks < 2 ? 1.f : -1.f;
                        cB[ks][0] = (_Float16)(sg * v0.x); cB[ks][1] = (_Float16)(sg * v0.y); cB[ks][2] = (_Float16)(sg * v0.z); cB[ks][3] = (_Float16)(sg * v0.w);
                        cB[ks][4] = (_Float16)(sg * v1.x); cB[ks][5] = (_Float16)(sg * v1.y); cB[ks][6] = (_Float16)(sg * v1.z); cB[ks][7] = (_Float16)(sg * v1.w);
                    }
                    const float dk = dsk[g * 16 + fr];
                    float sr = 0.f, si = 0.f;
                    for (int c2 = 0; c2 < c; ++c2) {
                        const f32x2 e = *(const f32x2*)(E + ((size_t)((b * 16 + g) * 32 + c2) * 64 + lane) * 2);
                        const float nsr = P.a64r * sr - P.a64i * si + e.x, nsi = P.a64r * si + P.a64i * sr + e.y; sr = nsr; si = nsi;
                    }
                    const size_t tok0 = (size_t)b * SEQ + c * 64;
                    for (int blk = 0; blk < 4; ++blk) {
                        LDS_WAIT();
                        ssm_load_u(U, tok0 + blk * 16, g, ublk, lane);
                        LDS_WAIT();
#pragma unroll
                        for (int t = 0; t < 16; ++t) {
                            ssm_step(P, ublk + t * 16, sr, si);
                            S16[t * 136 + lane] = f2h(sr); S16[t * 136 + 64 + lane] = f2h(si);
                        }
                        LDS_WAIT();
                        f32x4 acc = {0.f, 0.f, 0.f, 0.f};
#pragma unroll
                        for (int ks = 0; ks < 4; ++ks) { const half8 a = *(const LAS half8*)(S16 + fr * 136 + ks * 32 + fq * 8); acc = __builtin_amdgcn_mfma_f32_16x16x32_f16(a, cB[ks], acc, 0, 0, 0); }
#pragma unroll
                        for (int j = 0; j < 4; ++j) { const int t = fq * 4 + j; const float y = acc[j] + dk * ublk[t * 16 + fr];
                            GB[(tok0 + blk * 16 + t) * 256 + g * 16 + fr] = f2h(gelu_tanh(y)); }
                    }
                }
#endif
                }
                grid.sync();
                { PHASE_PTRS pg8::Gemm g{GB, W + W_GLU + (size_t)li * 256 * 256, MTOK, 256, 256}; pg8::StaticOrder S; S.init(MTOK, 256, G, bid);
                  pg8::EpiGLU Ep{GB, PIN(18) + li * 256, CAT};
#ifndef NO_GLU
 pg8::gemm_phase<pg8::EpiGLU>(lds, g, S, Ep, wave0);
#endif
 }
                grid.sync();
                rsel = 1;
            } else {
                { PHASE_PTRS pg8::Gemm g{X, W + W_CDIN + (size_t)li * CD_IN * DM, MTOK, CD_IN, DM}; pg8::StaticOrder S; S.init(MTOK, CD_IN, G, bid);
                  pg8::EpiInCD Ep{HCD};
#ifndef NO_INCD
 pg8::gemm_phase<pg8::EpiInCD>(lds, g, S, Ep, wave0);
#endif
 }
                grid.sync();
                {
                PHASE_PTRS THREAD_VARS
                for (size_t idx = gtid; idx < (size_t)MTOK * 64; idx += NT) {
                    const size_t tok = idx >> 6; const int j = (int)idx & 63, t = (int)tok & 2047, w = 2 << (j >> 4);
                    const u16* px = HCD + tok * CD_IN + j * 8;
                    const half8 x0 = *(const half8*)px;
                    float a[8];
#pragma unroll
                    for (int e = 0; e < 8; ++e) a[e] = (float)x0[e];
                    const int n = t < w - 1 ? t : w - 1;
                    for (int s = 1; s <= n; ++s) { const half8 xs = *(const half8*)(px - (size_t)s * CD_IN);
#pragma unroll
                        for (int e = 0; e < 8; ++e) a[e] += (float)xs[e]; }
                    const float inv = 1.0f / (float)(n + 1);
                    u32x4 o; o.x = pkh(a[0] * inv - (float)x0[0], a[1] * inv - (float)x0[1]); o.y = pkh(a[2] * inv - (float)x0[2], a[3] * inv - (float)x0[3]);
                    o.z = pkh(a[4] * inv - (float)x0[4], a[5] * inv - (float)x0[5]); o.w = pkh(a[6] * inv - (float)x0[6], a[7] * inv - (float)x0[7]);
                    *(u32x4*)(CAT + tok * DM + j * 8) = o;
                }
#ifndef NO_SGU
                {
                    const float* lg = PIN(23) + li * 512; const float* lb = PIN(24) + li * 512; const float* bsp = PIN(26) + li * 512;
                    LAS u16* VTL = (LAS u16*)lds; LAS f32x2* stats = (LAS f32x2*)(lds + 40960);
                    const int fr = lane & 15, fq = lane >> 4;
                    for (int task = bid; task < 512; task += G) {
                        const size_t tok0 = (size_t)task * 128;
                        for (int i = 0; i < 16; ++i) {
                            const int tk = wave * 16 + i;
                            const half8 v = *(const half8*)(HCD + (tok0 + tk) * CD_IN + 1024 + lane * 8);
                            float s = 0.f;
#pragma unroll
                            for (int e = 0; e < 8; ++e) s += (float)v[e];
                            const float mean = wave_sum(s) * (1.0f / 512.0f); float q = 0.f;
#pragma unroll
                            for (int e = 0; e < 8; ++e) { const float d = (float)v[e] - mean; q += d * d; }
                            const float rstd = 1.0f / sqrtf(wave_sum(q) * (1.0f / 512.0f) + LN_EPS);
                            if (lane == 0) stats[tk] = (f32x2){mean, rstd};
                        }
                        __syncthreads();
                        for (int hh = 0; hh < 4; ++hh) {
                            for (int r = 0; r < 4; ++r) {
                                const int vt = tid + 512 * r, s = vt & 127, c8 = vt >> 7;
                                const half8 v = *(const half8*)(HCD + (tok0 + s) * CD_IN + 1024 + hh * 128 + c8 * 8);
                                const f32x2 st = stats[s];
                                const f32x4 g0 = *(const f32x4*)(lg + hh * 128 + c8 * 8), g1 = *(const f32x4*)(lg + hh * 128 + c8 * 8 + 4);
                                const f32x4 b0 = *(const f32x4*)(lb + hh * 128 + c8 * 8), b1 = *(const f32x4*)(lb + hh * 128 + c8 * 8 + 4);
#pragma unroll
                                for (int e = 0; e < 8; ++e) { const float gg = e < 4 ? g0[e & 3] : g1[e & 3], bb = e < 4 ? b0[e & 3] : b1[e & 3];
                                    VTL[(c8 * 8 + e) * 136 + s] = f2h(((float)v[e] - st.x) * st.y * gg + bb); }
                            }
                            __syncthreads();
                            half8 a[4];
#pragma unroll
                            for (int ks = 0; ks < 4; ++ks) a[ks] = *(const LAS half8*)(VTL + (16 * wave + fr) * 136 + 32 * ks + fq * 8);
                            const u16* wsb = WS16 + (size_t)(li * 4 + hh) * 128 * 128;
#pragma unroll
                            for (int tt = 0; tt < 8; ++tt) {
                                f32x4 acc = {0.f, 0.f, 0.f, 0.f};
#pragma unroll
                                for (int ks = 0; ks < 4; ++ks) if (32 * ks <= 16 * tt + 15) {
                                    const half8 bf = *(const half8*)(wsb + (size_t)(16 * tt + fr) * 128 + 32 * ks + fq * 8);
                                    acc = __builtin_amdgcn_mfma_f32_16x16x32_f16(a[ks], bf, acc, 0, 0, 0);
                                }
                                const size_t tok = tok0 + 16 * tt + fr; const float bs = bsp[hh * 128 + 16 * tt + fr];
                                const half4 uu = *(const half4*)(HCD + tok * CD_IN + 512 + hh * 128 + 16 * wave + fq * 4);
                                u32x2 o; o.x = pkh((float)uu.x * (acc.x + bs), (float)uu.y * (acc.y + bs)); o.y = pkh((float)uu.z * (acc.z + bs), (float)uu.w * (acc.w + bs));
                                *(u32x2*)(CAT + tok * DM + 512 + hh * 128 + 16 * wave + fq * 4) = o;
                            }
                            __syncthreads();
                        }
                    }
                }
#endif
                }
                grid.sync();
                rsel = 2;
            }
            { PHASE_PTRS
              const int ls2 = l * 2 + (sub >> 1);
              const u16* rA = rsel == 0 ? H : CAT;
              const u16* rB = rsel == 0 ? W + W_D + (size_t)ls2 * DM * DFF : (rsel == 1 ? W + W_ABOUT + (size_t)li * DM * DM : W + W_CDOUT + (size_t)li * DM * DM);
              const pg8::Gemm gr{rA, rB, MTOK, DM, rsel == 0 ? DFF : DM}; const float rs = rsel == 0 ? 0.5f : 1.0f;
              pg8::StaticOrder S; S.init(MTOK, DM, G, bid); pg8::EpiResid Ep{X, Y, rs};
#ifndef NO_RESID
 pg8::gemm_phase<pg8::EpiResid>(lds, gr, S, Ep, wave0);
#endif
 }
            grid.sync();
            {
                PHASE_PTRS THREAD_VARS
                const float* gam = PIN(1) + (size_t)(l * 3 + sub) * DM; const float* bet = PIN(2) + (size_t)(l * 3 + sub) * DM;
                const bool fin = (l == DEPTH - 1 && sub == 2);
                f32x4 gv[4], bv[4];
#pragma unroll
                for (int j = 0; j < 4; ++j) { gv[j] = *(const f32x4*)(gam + 4 * lane + 256 * j); bv[j] = *(const f32x4*)(bet + 4 * lane + 256 * j); }
                for (int row = gw; row < MTOK; row += NGW) {
                    float* yr = Y + (size_t)row * DM + 4 * lane;
                    f32x4 v[4]; float s = 0.f;
#pragma unroll
                    for (int j = 0; j < 4; ++j) { v[j] = *(const f32x4*)(yr + 256 * j); s += (v[j].x + v[j].y) + (v[j].z + v[j].w); }
                    const float mean = wave_sum(s) * (1.0f / DM); float q = 0.f;
#pragma unroll
                    for (int j = 0; j < 4; ++j) { v[j] = v[j] - mean; q += (v[j].x * v[j].x + v[j].y * v[j].y) + (v[j].z * v[j].z + v[j].w * v[j].w); }
                    const float rstd = 1.0f / sqrtf(wave_sum(q) * (1.0f / DM) + LN_EPS);
#pragma unroll
                    for (int j = 0; j < 4; ++j) {
                        const f32x4 o = v[j] * rstd * gv[j] + bv[j];
                        if (fin) *(f32x4*)(yr + 256 * j) = o;
                        else { u32x2 w; w.x = pkh(o.x, o.y); w.y = pkh(o.z, o.w); *(u32x2*)(X + (size_t)row * DM + 4 * lane + 256 * j) = w; }
                    }
                }
            }
            if (!(l == DEPTH - 1 && sub == 2)) grid.sync();
        }
    }
}

extern "C" void kernel_launch(void* const* d_in, const int* in_sizes, int n_in, void* d_out, int out_size, void* d_ws, size_t ws_size, hipStream_t stream) {
    static int grid_blocks = 0;
    if (grid_blocks == 0) {
        if (n_in != 27 || out_size != MTOK * DM || ws_size < WS_END) { fprintf(stderr, "kernel_launch: unexpected shapes (n_in %d, out %d, ws %zu)\n", n_in, out_size, ws_size); grid_blocks = -1; return; }
        int dev = 0, cus = 0, per_cu = 0;
        hipGetDevice(&dev);
        hipDeviceGetAttribute(&cus, hipDeviceAttributeMultiprocessorCount, dev);
        if (hipFuncSetAttribute((const void*)fwd_megakernel, hipFuncAttributeMaxDynamicSharedMemorySize, LDS_BYTES) != hipSuccess) { fprintf(stderr, "kernel_launch: hipFuncSetAttribute failed\n"); grid_blocks = -1; return; }
        hipOccupancyMaxActiveBlocksPerMultiprocessor(&per_cu, (const void*)fwd_megakernel, 512, LDS_BYTES);
        if (per_cu < 1) per_cu = 1;
        grid_blocks = cus * 1;
        (void)hipGetLastError();
    }
    if (grid_blocks < 0) return;
    Params p{};
    for (int i = 0; i < 27; ++i) p.in[i] = (const float*)d_in[i];
    p.out = (float*)d_out; p.ws = (unsigned char*)d_ws;
    void* args[] = {&p};
    hipError_t e = hipLaunchCooperativeKernel((const void*)fwd_megakernel, dim3(grid_blocks), dim3(512), args, LDS_BYTES, stream);
    if (e != hipSuccess) fprintf(stderr, "cooperative launch failed: %s (grid %d)\n", hipGetErrorString(e), grid_blocks);
}
```

```cpp
#include <hip/hip_runtime.h>
#include <hip/hip_cooperative_groups.h>
#include <cstdio>
#include <cstdint>
namespace cg = cooperative_groups;

#define LAS __attribute__((address_space(3)))
typedef unsigned short u16;
typedef _Float16 half8 __attribute__((ext_vector_type(8)));
typedef _Float16 half4 __attribute__((ext_vector_type(4)));
typedef _Float16 half2 __attribute__((ext_vector_type(2)));
typedef float f32x4 __attribute__((ext_vector_type(4)));
typedef float f32x2 __attribute__((ext_vector_type(2)));
typedef unsigned u32x4 __attribute__((ext_vector_type(4)));
typedef unsigned u32x2 __attribute__((ext_vector_type(2)));

constexpr int DM = 1024, BATCH = 32, SEQ = 2048, DEPTH = 4, MTOK = BATCH * SEQ, DFF = 2816;
constexpr int NGU = 2 * DFF;
constexpr int AB_IN = 2560, CD_IN = 1536;
constexpr float ALPHA = 1.681792830507429f;
constexpr float LN_EPS = 1e-5f;
constexpr float LOG2E = 1.4426950408889634f;

constexpr size_t MiB = 1u << 20;
constexpr size_t WS_X = 0;
constexpr size_t WS_H = 128 * MiB;
constexpr size_t WS_Q = WS_H, WS_K = WS_H + 96 * MiB, WS_VT = WS_H + 192 * MiB, WS_U = WS_H + 288 * MiB;
constexpr size_t WS_HCD = WS_H;
constexpr size_t WS_CAT = 480 * MiB;
constexpr size_t WS_G = 608 * MiB;
constexpr size_t WS_E = 640 * MiB;
constexpr size_t WS_WS16 = 648 * MiB;
constexpr size_t WS_SSMT = 649 * MiB;
constexpr size_t WS_W = 650 * MiB;
constexpr size_t W_GU = 0;
constexpr size_t W_D = W_GU + (size_t)8 * NGU * DM;
constexpr size_t W_ABIN = W_D + (size_t)8 * DM * DFF;
constexpr size_t W_ABOUT = W_ABIN + (size_t)2 * AB_IN * DM;
constexpr size_t W_CDIN = W_ABOUT + (size_t)2 * DM * DM;
constexpr size_t W_CDOUT = W_CDIN + (size_t)2 * CD_IN * DM;
constexpr size_t W_GLU = W_CDOUT + (size_t)2 * DM * DM;
constexpr size_t W_END = W_GLU + (size_t)2 * 256 * 256;
constexpr size_t WS_END = WS_W + W_END * 2;
static_assert(WS_END <= 1024 * MiB, "workspace map");

constexpr int LDS_BYTES = 131072 + 1024;

__device__ __forceinline__ unsigned pkh(float a, float b) { half2 v = {(_Float16)a, (_Float16)b}; return __builtin_bit_cast(unsigned, v); }
__device__ __forceinline__ float h2f(u16 b) { return (float)__builtin_bit_cast(_Float16, b); }
__device__ __forceinline__ u16 f2h(float f) { return __builtin_bit_cast(u16, (_Float16)f); }
__device__ __forceinline__ float wave_sum(float v) {
#pragma unroll
    for (int o = 1; o < 64; o <<= 1) v += __shfl_xor(v, o);
    return v;
}
__device__ __forceinline__ float sigmoid_f(float x) { return __builtin_amdgcn_rcpf(1.0f + __builtin_amdgcn_exp2f(-x * LOG2E)); }
__device__ __forceinline__ float gelu_tanh(float x) { const float u = 1.5957691216057308f * x * (1.0f + 0.044715f * x * x); return x * sigmoid_f(u); }
#define LDS_WAIT() asm volatile("s_waitcnt lgkmcnt(0)" ::: "memory")
__device__ __forceinline__ int fresh_lane() { int l; asm volatile("v_mbcnt_lo_u32_b32 %0, -1, 0\n\tv_mbcnt_hi_u32_b32 %0, -1, %0" : "=v"(l)); return l; }
#define THREAD_VARS int wave = wave0; asm volatile("" : "+s"(wave)); const int lane = fresh_lane(), tid = wave * 64 + lane; const int gw = bid * 8 + wave, NGW = G * 8; const size_t gtid = (size_t)bid * 512 + tid, NT = (size_t)G * 512; (void)lane; (void)gw; (void)NGW; (void)gtid; (void)NT;

namespace pg8 {
constexpr int BM = 256, BK = 64, HALF = 128, HTB = HALF * BK * 2, STAGE_BYTES = 8 * HTB, NXCD = 8, WGM = 8;
__device__ __forceinline__ int lds_byte(int r, int c) { const int st = (r >> 4) * 2 + (c >> 5), rr = r & 15, cc = c & 31, ob = rr * 64 + cc * 2; return st * 1024 + (ob ^ (((ob >> 9) & 1) << 5)); }
__device__ __forceinline__ void stage_rc(int b, int& R, int& C) { const int st = b / 1024, sb = b % 1024, swz = sb ^ (((sb >> 9) & 1) << 5); R = (st >> 1) * 16 + swz / 64; C = (st & 1) * 32 + (swz % 64) / 2; }
__device__ __forceinline__ int perm32(int rho) { const int n = rho >> 4, i = rho & 15; return 8 * (i >> 2) + 4 * n + (i & 3); }

struct Unit { int pm, pn; };
struct Gemm { const u16* A; const u16* Bt; int M, N, K; };
struct StaticOrder {
    int nM, nN, nwg, G, c;
    __device__ void init(int M, int N, int G_, int c_) { nM = M / BM; nN = N / BM; nwg = nM * nN; G = G_; c = c_; }
    __device__ bool next(int i, Unit& u) const {
        const long L = (long)i * G + c; if (L >= nwg) return false;
        int wgid = (int)L; { const int q = nwg / NXCD, r = nwg % NXCD, xcd = wgid % NXCD, off = wgid / NXCD; wgid = (xcd < r ? xcd * (q + 1) : r * (q + 1) + (xcd - r) * q) + off; }
        const int nig = WGM * nN, gid = wgid / nig, fm = gid * WGM, gsz = (nM - fm) < WGM ? (nM - fm) : WGM;
        u.pm = fm + ((wgid % nig) % gsz); u.pn = (wgid % nig) / gsz; return true;
    }
};


struct EpiSwiGLU {
    static constexpr bool PERM = true;
    u16* H;
    __device__ __forceinline__ void operator()(const f32x4 (&acc)[2][2][4][2], const Unit& u, int wr, int wc, int fr, int fq) const {
        const int row0 = u.pm * BM + wr * 64 + fr; const int col0 = u.pn * HALF + wc * 32 + 8 * fq;
#pragma unroll
        for (int ai = 0; ai < 2; ++ai)
#pragma unroll
            for (int m = 0; m < 4; ++m) {
                u16* rowp = H + (size_t)(row0 + ai * HALF + m * 16) * DFF + col0;
                float o[8];
#pragma unroll
                for (int n = 0; n < 2; ++n)
#pragma unroll
                    for (int j = 0; j < 4; ++j) { const float g = acc[ai][0][m][n][j], up = acc[ai][1][m][n][j]; o[n * 4 + j] = g * sigmoid_f(g) * up; }
                u32x4 w; w.x = pkh(o[0], o[1]); w.y = pkh(o[2], o[3]); w.z = pkh(o[4], o[5]); w.w = pkh(o[6], o[7]);
                *(u32x4*)rowp = w;
            }
    }
};
struct EpiResid {
    static constexpr bool PERM = false;
    const u16* X; float* Y; float s;
    __device__ __forceinline__ void operator()(const f32x4 (&acc)[2][2][4][2], const Unit& u, int wr, int wc, int fr, int fq) const {
        const int row0 = u.pm * BM + wr * 64 + fr; const int col0 = u.pn * BM + wc * 32 + 4 * fq;
#pragma unroll
        for (int ai = 0; ai < 2; ++ai)
#pragma unroll
            for (int m = 0; m < 4; ++m) {
                const size_t off = (size_t)(row0 + ai * HALF + m * 16) * DM + col0;
#pragma unroll
                for (int bj = 0; bj < 2; ++bj)
#pragma unroll
                    for (int n = 0; n < 2; ++n) {
                        const half4 xv = *(const half4*)(X + off + bj * HALF + n * 16);
                        const f32x4 a = acc[ai][bj][m][n];
                        f32x4 o; o.x = ALPHA * (float)xv.x + s * a.x; o.y = ALPHA * (float)xv.y + s * a.y; o.z = ALPHA * (float)xv.z + s * a.z; o.w = ALPHA * (float)xv.w + s * a.w;
                        *(f32x4*)(Y + off + bj * HALF + n * 16) = o;
                    }
            }
    }
};
struct EpiInAB {
    static constexpr bool PERM = true;
    u16* Q; u16* Kb; u16* VT; float* U;
    __device__ __forceinline__ void operator()(const f32x4 (&acc)[2][2][4][2], const Unit& u, int wr, int wc, int fr, int fq) const {
        const int row0 = u.pm * BM + wr * 64 + fr; const int pn = u.pn;
#pragma unroll
        for (int ai = 0; ai < 2; ++ai)
#pragma unroll
            for (int m = 0; m < 4; ++m) {
                const int row = row0 + ai * HALF + m * 16;
#pragma unroll
                for (int bj = 0; bj < 2; ++bj) {
                    const f32x4 v0 = acc[ai][bj][m][0], v1 = acc[ai][bj][m][1];
                    const int cl = bj * HALF + wc * 32 + 8 * fq;
                    if (pn < 6) {
                        const float sc = pn < 3 ? 0.125f : 1.0f;
                        u16* dst = (pn < 3 ? Q + (size_t)row * 768 + pn * 256 : Kb + (size_t)row * 768 + (pn - 3) * 256) + cl;
                        u32x4 w; w.x = pkh(v0.x * sc, v0.y * sc); w.y = pkh(v0.z * sc, v0.w * sc); w.z = pkh(v1.x * sc, v1.y * sc); w.w = pkh(v1.z * sc, v1.w * sc);
                        *(u32x4*)dst = w;
                    } else if (pn < 9) {
                        const int cv = (pn - 6) * 256 + cl, h = cv >> 6, d = cv & 63;
                        const int b = row >> 11, t = row & 2047, ch = t >> 6, tk = t & 63;
                        u16* dst = VT + ((((size_t)(b * 12 + h) * 32 + ch) * 64 + d) * 64) + tk;
                        dst[0 * 64] = f2h(v0.x); dst[1 * 64] = f2h(v0.y); dst[2 * 64] = f2h(v0.z); dst[3 * 64] = f2h(v0.w);
                        dst[4 * 64] = f2h(v1.x); dst[5 * 64] = f2h(v1.y); dst[6 * 64] = f2h(v1.z); dst[7 * 64] = f2h(v1.w);
                    } else {
                        float* dst = U + (size_t)row * 256 + cl;
                        *(f32x4*)dst = v0; *(f32x4*)(dst + 4) = v1;
                    }
                    asm volatile("" ::: "memory");
                }
            }
    }
};
struct EpiInCD {
    static constexpr bool PERM = true;
    u16* O;
    __device__ __forceinline__ void operator()(const f32x4 (&acc)[2][2][4][2], const Unit& u, int wr, int wc, int fr, int fq) const {
        const int row0 = u.pm * BM + wr * 64 + fr; const int col0 = u.pn * BM + wc * 32 + 8 * fq; const bool act = u.pn >= 2;
#pragma unroll
        for (int ai = 0; ai < 2; ++ai)
#pragma unroll
            for (int m = 0; m < 4; ++m) {
                u16* rowp = O + (size_t)(row0 + ai * HALF + m * 16) * CD_IN + col0;
#pragma unroll
                for (int bj = 0; bj < 2; ++bj) {
                    f32x4 v0 = acc[ai][bj][m][0], v1 = acc[ai][bj][m][1];
                    if (act) { v0.x = gelu_tanh(v0.x); v0.y = gelu_tanh(v0.y); v0.z = gelu_tanh(v0.z); v0.w = gelu_tanh(v0.w);
                               v1.x = gelu_tanh(v1.x); v1.y = gelu_tanh(v1.y); v1.z = gelu_tanh(v1.z); v1.w = gelu_tanh(v1.w); }
                    u32x4 w; w.x = pkh(v0.x, v0.y); w.y = pkh(v0.z, v0.w); w.z = pkh(v1.x, v1.y); w.w = pkh(v1.z, v1.w);
                    *(u32x4*)(rowp + bj * HALF) = w;
                    asm volatile("" ::: "memory");
                }
            }
    }
};
struct EpiGLU {
    static constexpr bool PERM = true;
    const u16* G; const float* bias; u16* CAT;
    __device__ __forceinline__ void operator()(const f32x4 (&acc)[2][2][4][2], const Unit& u, int wr, int wc, int fr, int fq) const {
        const int row0 = u.pm * BM + wr * 64 + fr; const int col0 = wc * 32 + 8 * fq;
#pragma unroll
        for (int ai = 0; ai < 2; ++ai)
#pragma unroll
            for (int m = 0; m < 4; ++m) {
                const int row = row0 + ai * HALF + m * 16;
#pragma unroll
                for (int bj = 0; bj < 2; ++bj) {
                    const int col = col0 + bj * HALF;
                    const half8 g = *(const half8*)(G + (size_t)row * 256 + col);
                    const f32x4 b0 = *(const f32x4*)(bias + col), b1 = *(const f32x4*)(bias + col + 4);
                    const f32x4 v0 = acc[ai][bj][m][0] + b0, v1 = acc[ai][bj][m][1] + b1;
                    float o[8];
                    o[0] = (float)g[0] * sigmoid_f(v0.x); o[1] = (float)g[1] * sigmoid_f(v0.y); o[2] = (float)g[2] * sigmoid_f(v0.z); o[3] = (float)g[3] * sigmoid_f(v0.w);
                    o[4] = (float)g[4] * sigmoid_f(v1.x); o[5] = (float)g[5] * sigmoid_f(v1.y); o[6] = (float)g[6] * sigmoid_f(v1.z); o[7] = (float)g[7] * sigmoid_f(v1.w);
                    u32x4 w; w.x = pkh(o[0], o[1]); w.y = pkh(o[2], o[3]); w.z = pkh(o[4], o[5]); w.w = pkh(o[6], o[7]);
                    *(u32x4*)(CAT + (size_t)row * DM + 768 + col) = w;
                    asm volatile("" ::: "memory");
                }
            }
    }
};

template <class Epi>
__device__ __forceinline__ void gemm_phase(LAS unsigned char* lds, const Gemm g, const StaticOrder& S, const Epi& E, const int wid_in) {
    int wid = wid_in; asm volatile("" : "+s"(wid));
    const int lane = fresh_lane(), tid = wid * 64 + lane, wr = wid >> 2, wc = wid & 3, fr = lane & 15, fq = lane >> 4;
    const int K = g.K, nt = K / BK;
    unsigned voffA[2], voffB[2];
#pragma unroll
    for (int i = 0; i < 2; ++i) { int R, C; stage_rc(tid * 16 + i * 8192, R, C); const int Rb = Epi::PERM ? ((R & ~31) + perm32(R & 31)) : R;
        voffA[i] = (unsigned)(R * K + C) * 2u; voffB[i] = (unsigned)(Rb * K + C) * 2u; }
    const size_t kstep = (size_t)(BK * 2);
    const size_t hstep = (size_t)HALF * K * 2;
    const size_t tstep = 2 * hstep;
    const unsigned lbase = (unsigned)(size_t)lds + (unsigned)wid * 1024u;
    const int aoff = lds_byte(wr * 64 + fr, fq * 8), boff = lds_byte(wc * 32 + fr, fq * 8);
#define PG8_SA(b, h) (((b) * 2 + (h)) * HTB)
#define PG8_SB(b, h) ((4 + (b) * 2 + (h)) * HTB)
#define PG8_STAGE1(bufoff, gbase, voff, I) asm volatile("s_add_u32 m0, %1, %3\n\ts_nop 0\n\tglobal_load_lds_dwordx4 %0, %2" \
            :: "v"((voff)[I]), "s"(lbase), "s"((const void*)(gbase)), "i"((bufoff) + (I) * 8192) : "memory", "m0", "scc")
#define PG8_STAGE(bufoff, gbase, voff) do { PG8_STAGE1(bufoff, gbase, voff, 0); PG8_STAGE1(bufoff, gbase, voff, 1); } while (0)
#define PG8_LDA(dst, b, h) do { _Pragma("unroll") for (int m = 0; m < 4; ++m) _Pragma("unroll") for (int k = 0; k < 2; ++k) dst[m][k] = *(const LAS half8*)(lds + PG8_SA(b, h) + aoff + m * 2048 + k * 1024); } while (0)
#define PG8_LDB(dst, b, h) do { _Pragma("unroll") for (int n = 0; n < 2; ++n) _Pragma("unroll") for (int k = 0; k < 2; ++k) dst[n][k] = *(const LAS half8*)(lds + PG8_SB(b, h) + boff + n * 2048 + k * 1024); } while (0)
#define PG8_MMA(ai, bj, At, Bt) do { __builtin_amdgcn_s_setprio(1); _Pragma("unroll") for (int m = 0; m < 4; ++m) _Pragma("unroll") for (int n = 0; n < 2; ++n) _Pragma("unroll") for (int k = 0; k < 2; ++k) \
        acc[ai][bj][m][n] = __builtin_amdgcn_mfma_f32_16x16x32_f16(Bt[n][k], At[m][k], acc[ai][bj][m][n], 0, 0, 0); __builtin_amdgcn_s_setprio(0); } while (0)
#define PG8_WAIT_V(n) asm volatile("s_waitcnt vmcnt(" #n ")" ::: "memory")
#define PG8_WAIT_L(n) asm volatile("s_waitcnt lgkmcnt(" #n ")" ::: "memory")
#define PG8_BAR __builtin_amdgcn_s_barrier()
#define PG8_SCHED __builtin_amdgcn_sched_barrier(0)
    Unit cur, nxt; int ui = 0;
    if (!S.next(0, cur)) return;
    f32x4 acc[2][2][4][2];
#pragma unroll
    for (int a = 0; a < 2; ++a)
#pragma unroll
        for (int b = 0; b < 2; ++b)
#pragma unroll
            for (int m = 0; m < 4; ++m)
#pragma unroll
                for (int n = 0; n < 2; ++n) acc[a][b][m][n] = (f32x4){0.f, 0.f, 0.f, 0.f};
    half8 At[4][2], B0[2][2], B1[2][2];
    const char* cA = (const char*)g.A + (size_t)cur.pm * tstep; const char* cB = (const char*)g.Bt + (size_t)cur.pn * tstep;
    PG8_STAGE(PG8_SB(0, 0), cB, voffB); PG8_STAGE(PG8_SB(0, 1), cB + hstep, voffB); PG8_STAGE(PG8_SA(0, 0), cA, voffA); PG8_STAGE(PG8_SA(0, 1), cA + hstep, voffA);
    if (wr == 1) PG8_BAR;
    PG8_WAIT_V(2); PG8_BAR;
    PG8_STAGE(PG8_SB(1, 0), cB + kstep, voffB); PG8_STAGE(PG8_SA(1, 0), cA + kstep, voffA); PG8_STAGE(PG8_SB(1, 1), cB + hstep + kstep, voffB);
    PG8_WAIT_V(6); PG8_BAR;
    for (;;) {
        const bool has_next = S.next(ui + 1, nxt);
        const char* nA = has_next ? (const char*)g.A + (size_t)nxt.pm * tstep : cA; const char* nB = has_next ? (const char*)g.Bt + (size_t)nxt.pn * tstep : cB;
        for (int t = 0; t < nt; t += 2) {
            const bool last = (t == nt - 2);
            const char* a1 = cA + (size_t)(t + 1) * kstep;
            const char* a2 = last ? nA : cA + (size_t)(t + 2) * kstep; const char* b2 = last ? nB : cB + (size_t)(t + 2) * kstep;
            const char* a3 = a2 + kstep; const char* b3 = b2 + kstep;
            PG8_LDB(B0, 0, 0); PG8_LDB(B1, 0, 1); PG8_SCHED; PG8_LDA(At, 0, 0); PG8_STAGE(PG8_SA(1, 1), a1 + hstep, voffA);
            PG8_WAIT_V(8); PG8_WAIT_L(0); PG8_BAR; PG8_MMA(0, 0, At, B0); PG8_MMA(0, 1, At, B1); PG8_BAR; PG8_SCHED;
            PG8_LDA(At, 0, 1); PG8_STAGE(PG8_SB(0, 0), b2, voffB); PG8_STAGE(PG8_SB(0, 1), b2 + hstep, voffB); PG8_STAGE(PG8_SA(0, 0), a2, voffA);
            PG8_WAIT_V(8); PG8_WAIT_L(0); PG8_BAR; PG8_MMA(1, 0, At, B0); PG8_MMA(1, 1, At, B1); PG8_BAR; PG8_SCHED;
            PG8_LDB(B0, 1, 0); PG8_LDB(B1, 1, 1); PG8_SCHED; PG8_LDA(At, 1, 0); PG8_STAGE(PG8_SA(0, 1), a2 + hstep, voffA);
            PG8_WAIT_V(8); PG8_WAIT_L(0); PG8_BAR; PG8_MMA(0, 0, At, B0); PG8_MMA(0, 1, At, B1); PG8_BAR; PG8_SCHED;
            PG8_LDA(At, 1, 1); PG8_STAGE(PG8_SB(1, 0), b3, voffB); PG8_STAGE(PG8_SB(1, 1), b3 + hstep, voffB); PG8_STAGE(PG8_SA(1, 0), a3, voffA);
            PG8_WAIT_V(8); PG8_WAIT_L(0); PG8_BAR; PG8_MMA(1, 0, At, B0); PG8_MMA(1, 1, At, B1); PG8_BAR; PG8_SCHED;
        }
        if (wr == 0) PG8_BAR;
        E(acc, cur, wr, wc, fr, fq);
        if (!has_next) break;
#pragma unroll
        for (int a = 0; a < 2; ++a)
#pragma unroll
            for (int b = 0; b < 2; ++b)
#pragma unroll
                for (int m = 0; m < 4; ++m)
#pragma unroll
                    for (int n = 0; n < 2; ++n) acc[a][b][m][n] = (f32x4){0.f, 0.f, 0.f, 0.f};
        cur = nxt; cA = nA; cB = nB; ++ui;
        if (wr == 1) PG8_BAR;
    }
    PG8_WAIT_V(0);
    PG8_BAR;
#undef PG8_SA
#undef PG8_SB
#undef PG8_STAGE
#undef PG8_STAGE1
#undef PG8_LDA
#undef PG8_LDB
#undef PG8_MMA
#undef PG8_WAIT_V
#undef PG8_WAIT_L
#undef PG8_BAR
#undef PG8_SCHED
}
}

__device__ __forceinline__ void conv_items(const float* W, int K, int N, u16* WT, int ldd, int coff, int mode, LAS float* scr, int lane, int gw, int NGW, int& base) {
    const int nblk = N / 32, nitems = (K / 64) * nblk;
    const int first = (gw - (base % NGW) + NGW) % NGW;
    for (int it = first; it < nitems; it += NGW) {
        const int kb = it / nblk, nb = it % nblk, k0 = 64 * kb, n0 = 32 * nb;
        int drow0 = n0; if (mode) drow0 = (n0 >> 7) * 256 + (n0 & 127) + (mode == 2 ? 128 : 0);
#pragma unroll 8
        for (int i = 0; i < 32; ++i) { const int kk = 2 * i + (lane >> 5); scr[kk * 33 + (lane & 31)] = W[(size_t)(k0 + kk) * N + n0 + (lane & 31)]; }
        LDS_WAIT();
        const int c = lane & 7;
#pragma unroll
        for (int j = 0; j < 4; ++j) { const int n = (lane >> 3) + 8 * j; const LAS float* s = scr + (8 * c) * 33 + n;
            u32x4 o; o.x = pkh(s[0 * 33], s[1 * 33]); o.y = pkh(s[2 * 33], s[3 * 33]); o.z = pkh(s[4 * 33], s[5 * 33]); o.w = pkh(s[6 * 33], s[7 * 33]);
            *(u32x4*)(WT + (size_t)(drow0 + n) * ldd + coff + k0 + 8 * c) = o; }
        LDS_WAIT();
    }
    base += nitems;
}

struct Params { const float* in[27]; float* out; unsigned char* ws; };

constexpr int ATT_RS = 72;
__device__ __forceinline__ void attn_block_task(LAS u16* lds16, const u16* Q, const u16* Kb, const u16* VT, const float* rb, u16* cat, int b, int h, int cp, int wave, int lane) {
    const int fr = lane & 15, fq = lane >> 4, tid = wave * 64 + lane;
    const int wc = wave >> 2, qq = wave & 3;
    const int c0 = cp * 2, c = c0 + wc;
    const size_t qtok = (size_t)b * SEQ + c * 64 + qq * 16 + fr;
    half8 qf[2];
#pragma unroll
    for (int s = 0; s < 2; ++s) qf[s] = *(const half8*)(Q + qtok * 768 + h * 64 + s * 32 + fq * 8);
    const float b256 = rb[256];
    const int qi = qq * 16 + fr;
    float m = -1e30f, l = 0.f;
    f32x4 O[4];
#pragma unroll
    for (int dt = 0; dt < 4; ++dt) O[dt] = (f32x4){0.f, 0.f, 0.f, 0.f};
    const int srow = tid >> 3, spc = tid & 7;
    LAS u16* Kl = lds16; LAS u16* Vl = lds16 + 2 * 64 * ATT_RS;
    const int jb0 = c0 >= 8 ? 0 : 8 - c0;
    const u16* kg = Kb + ((size_t)b * SEQ + srow) * 768 + h * 64 + spc * 8;
    const u16* vg = VT + (((size_t)(b * 12 + h) * 32) * 64 + srow) * 64 + spc * 8;
    {
        const int cc = c0 - 8 + jb0;
        const u32x4 kreg = *(const u32x4*)(kg + (size_t)cc * 64 * 768), vreg = *(const u32x4*)(vg + (size_t)cc * 64 * 64);
        *(LAS u32x4*)(Kl + srow * ATT_RS + spc * 8) = kreg; *(LAS u32x4*)(Vl + srow * ATT_RS + spc * 8) = vreg;
    }
    __syncthreads();
    for (int jb = jb0; jb < 10; ++jb) {
        const int buf = (jb - jb0) & 1;
        const bool more = jb + 1 < 10;
        u32x4 kreg = {0u, 0u, 0u, 0u}, vreg = {0u, 0u, 0u, 0u};
        if (more) { const int cc = c0 - 7 + jb; kreg = *(const u32x4*)(kg + (size_t)cc * 64 * 768); vreg = *(const u32x4*)(vg + (size_t)cc * 64 * 64); }
        const int j = jb - wc;
        if (j >= 0 && j <= 8) {
            const LAS u16* Kc = Kl + buf * 64 * ATT_RS; const LAS u16* Vc = Vl + buf * 64 * ATT_RS;
            f32x4 S[4];
#pragma unroll
            for (int ks2 = 0; ks2 < 2; ++ks2)
#pragma unroll
                for (int tt = 0; tt < 2; ++tt) {
                    const int krow = ks2 * 32 + (fr >> 2) * 8 + tt * 4 + (fr & 3);
                    const half8 k0 = *(const LAS half8*)(Kc + krow * ATT_RS + fq * 8), k1 = *(const LAS half8*)(Kc + krow * ATT_RS + 32 + fq * 8);
                    f32x4 a = {0.f, 0.f, 0.f, 0.f};
                    a = __builtin_amdgcn_mfma_f32_16x16x32_f16(k0, qf[0], a, 0, 0, 0);
                    a = __builtin_amdgcn_mfma_f32_16x16x32_f16(k1, qf[1], a, 0, 0, 0);
                    if (j >= 6) {
#pragma unroll
                        for (int e = 0; e < 4; ++e) { const int km = 64 * j + ks2 * 32 + fq * 8 + tt * 4 + e; int idx = 640 + qi - km; idx = idx > 256 ? 256 : idx; a[e] += rb[idx]; }
                    } else { a += b256; }
                    S[ks2 * 2 + tt] = a;
                }
            float mx = m;
#pragma unroll
            for (int i = 0; i < 4; ++i) mx = fmaxf(mx, fmaxf(fmaxf(S[i].x, S[i].y), fmaxf(S[i].z, S[i].w)));
            mx = fmaxf(mx, __shfl_xor(mx, 16)); mx = fmaxf(mx, __shfl_xor(mx, 32));
            const float sc = __builtin_amdgcn_exp2f((m - mx) * LOG2E);
            l *= sc;
#pragma unroll
            for (int dt = 0; dt < 4; ++dt) O[dt] = O[dt] * sc;
            m = mx;
            const float mxl = mx * LOG2E;
#pragma unroll
            for (int ks2 = 0; ks2 < 2; ++ks2) {
                half8 pf;
#pragma unroll
                for (int tt = 0; tt < 2; ++tt)
#pragma unroll
                    for (int e = 0; e < 4; ++e) { const float pe = __builtin_amdgcn_exp2f(S[2 * ks2 + tt][e] * LOG2E - mxl); l += pe; pf[tt * 4 + e] = (_Float16)pe; }
#pragma unroll
                for (int dt = 0; dt < 4; ++dt) {
                    const half8 vt = *(const LAS half8*)(Vc + (dt * 16 + fr) * ATT_RS + ks2 * 32 + fq * 8);
                    O[dt] = __builtin_amdgcn_mfma_f32_16x16x32_f16(vt, pf, O[dt], 0, 0, 0);
                }
            }
        }
        if (more) { *(LAS u32x4*)(Kl + (buf ^ 1) * 64 * ATT_RS + srow * ATT_RS + spc * 8) = kreg; *(LAS u32x4*)(Vl + (buf ^ 1) * 64 * ATT_RS + srow * ATT_RS + spc * 8) = vreg; }
        __syncthreads();
    }
    l += __shfl_xor(l, 16); l += __shfl_xor(l, 32);
    const float inv = 1.0f / l;
#pragma unroll
    for (int dt = 0; dt < 4; ++dt) {
        u32x2 w; w.x = pkh(O[dt].x * inv, O[dt].y * inv); w.y = pkh(O[dt].z * inv, O[dt].w * inv);
        *(u32x2*)(cat + qtok * DM + h * 64 + dt * 16 + fq * 4) = w;
    }
}

struct SsmP { float ar, ai, a64r, a64i; float bbr[16], bbi[16]; };
__device__ __forceinline__ void ssm_build(float* T, const float* a_re, const float* a_im, const float* log_dt, const float* b_re, const float* b_im, int g, int p) {
    const double dt = exp((double)log_dt[g]);
    const double are = (double)a_re[g * 64 + p], aim = (double)a_im[g * 64 + p];
    const double mag = exp(dt * are), ang = dt * aim;
    const double abr = mag * cos(ang), abi = mag * sin(ang);
    const double den = are * are + aim * aim, nr = abr - 1.0, ni = abi;
    const double cr = (nr * are + ni * aim) / den, ci = (ni * are - nr * aim) / den;
    const double m64 = exp(64.0 * dt * are), a64 = 64.0 * ang;
    T[0] = (float)abr; T[1] = (float)abi; T[2] = (float)(m64 * cos(a64)); T[3] = (float)(m64 * sin(a64));
    const float* br = b_re + (size_t)(g * 64 + p) * 16; const float* bi = b_im + (size_t)(g * 64 + p) * 16;
    for (int h = 0; h < 16; ++h) { const double r = br[h], i = bi[h]; T[4 + h] = (float)(cr * r - ci * i); T[20 + h] = (float)(cr * i + ci * r); }
}
__device__ __forceinline__ void ssm_setup(SsmP& P, const float* T) {
    const f32x4 a = *(const f32x4*)T; P.ar = a.x; P.ai = a.y; P.a64r = a.z; P.a64i = a.w;
#pragma unroll
    for (int h4 = 0; h4 < 4; ++h4) {
        const f32x4 r = *(const f32x4*)(T + 4 + 4 * h4), i = *(const f32x4*)(T + 20 + 4 * h4);
#pragma unroll
        for (int e = 0; e < 4; ++e) { P.bbr[4 * h4 + e] = r[e]; P.bbi[4 * h4 + e] = i[e]; }
    }
}
__device__ __forceinline__ void ssm_load_u(const float* U, size_t tok, int g, LAS float* ublk, int lane) {
    const f32x4 v = *(const f32x4*)(U + (tok + (lane >> 2)) * 256 + g * 16 + (lane & 3) * 4);
    *(LAS f32x4*)(ublk + (lane >> 2) * 16 + (lane & 3) * 4) = v;
}
__device__ __forceinline__ void ssm_step(const SsmP& P, const LAS float* ut, float& sr, float& si) {
    float bur = 0.f, bui = 0.f;
#pragma unroll
    for (int h4 = 0; h4 < 4; ++h4) { const f32x4 u = *(const LAS f32x4*)(ut + 4 * h4);
#pragma unroll
        for (int e = 0; e < 4; ++e) { bur += P.bbr[4 * h4 + e] * u[e]; bui += P.bbi[4 * h4 + e] * u[e]; } }
    const float nsr = P.ar * sr - P.ai * si + bur, nsi = P.ar * si + P.ai * sr + bui;
    sr = nsr; si = nsi;
}

#define PROBE_SEL 0
#define PROBE_BEGIN(sel) if (PROBE_SEL % 10 == (sel)) _pt0 = __builtin_amdgcn_s_memrealtime();
#define PROBE_END(sel) if (PROBE_SEL == (sel)) tacc += (unsigned)(__builtin_amdgcn_s_memrealtime() - _pt0);
#define GSYNC() do { PROBE_BEGIN(4) grid.sync(); PROBE_END(4) if (PROBE_SEL >= 10 && _pt0 != 0) { tacc += (unsigned)(__builtin_amdgcn_s_memrealtime() - _pt0); _pt0 = 0; } } while (0)
typedef const __attribute__((address_space(4))) Params* KP;
#define PHASE_PTRS KP kp = (KP)__builtin_amdgcn_kernarg_segment_ptr(); int G = G0, bid = bid0; asm volatile("" : "+s"(kp), "+s"(G), "+s"(bid)); unsigned char* ws = kp->ws; \
    u16* X = (u16*)(ws + WS_X); u16* H = (u16*)(ws + WS_H); u16* CAT = (u16*)(ws + WS_CAT); u16* GB = (u16*)(ws + WS_G); \
    u16* Qb = (u16*)(ws + WS_Q); u16* Kb = (u16*)(ws + WS_K); u16* VT = (u16*)(ws + WS_VT); float* U = (float*)(ws + WS_U); \
    u16* HCD = (u16*)(ws + WS_HCD); float* E = (float*)(ws + WS_E); u16* WS16 = (u16*)(ws + WS_WS16); u16* W = (u16*)(ws + WS_W); float* SSMT = (float*)(ws + WS_SSMT); \
    float* Y = kp->out; (void)X; (void)H; (void)CAT; (void)GB; (void)Qb; (void)Kb; (void)VT; (void)U; (void)HCD; (void)E; (void)WS16; (void)W; (void)SSMT; (void)Y;
#define PIN(k) ((const float*)kp->in[k])
__global__ void __launch_bounds__(512, 2) fwd_megakernel(Params p) {
    extern __shared__ __attribute__((aligned(16))) unsigned char lds_raw[];
    LAS unsigned char* lds = (LAS unsigned char*)lds_raw;
    cg::grid_group grid = cg::this_grid();
    const int G0 = gridDim.x, bid0 = blockIdx.x;
    const int wave0 = __builtin_amdgcn_readfirstlane((int)threadIdx.x >> 6);
    unsigned tacc = 0; unsigned long long _pt0 = 0; (void)_pt0;

    {
        PROBE_BEGIN(7)
        PHASE_PTRS THREAD_VARS
        LAS float* scr = (LAS float*)(lds + wave * 16384);
        int base = 0;
        for (int ls = 0; ls < 8; ++ls) {
            conv_items(PIN(3) + (size_t)ls * DM * DFF, DM, DFF, W + W_GU + (size_t)ls * NGU * DM, DM, 0, 1, scr, lane, gw, NGW, base);
            conv_items(PIN(4) + (size_t)ls * DM * DFF, DM, DFF, W + W_GU + (size_t)ls * NGU * DM, DM, 0, 2, scr, lane, gw, NGW, base);
            conv_items(PIN(5) + (size_t)ls * DFF * DM, DFF, DM, W + W_D + (size_t)ls * DM * DFF, DFF, 0, 0, scr, lane, gw, NGW, base);
        }
        for (int i = 0; i < 2; ++i) {
            conv_items(PIN(6) + (size_t)i * DM * AB_IN, DM, AB_IN, W + W_ABIN + (size_t)i * AB_IN * DM, DM, 0, 0, scr, lane, gw, NGW, base);
            conv_items(PIN(7) + (size_t)i * DM * DM, DM, DM, W + W_ABOUT + (size_t)i * DM * DM, DM, 0, 0, scr, lane, gw, NGW, base);
            conv_items(PIN(19) + (size_t)i * DM * CD_IN, DM, CD_IN, W + W_CDIN + (size_t)i * CD_IN * DM, DM, 0, 0, scr, lane, gw, NGW, base);
            conv_items(PIN(20) + (size_t)i * DM * DM + (size_t)512 * DM, 512, DM, W + W_CDOUT + (size_t)i * DM * DM, DM, 512, 0, scr, lane, gw, NGW, base);
            conv_items(PIN(17) + (size_t)i * 256 * 256, 256, 256, W + W_GLU + (size_t)i * 256 * 256, 256, 0, 0, scr, lane, gw, NGW, base);
        }
        for (size_t idx = gtid; idx < (size_t)2 * 512 * 1024; idx += NT) {
            const int i = (int)(idx >> 19), r = (int)(idx & 524287), row = r >> 10, n = r & 1023, gq = row >> 7;
            const float* pw = PIN(21) + (size_t)i * 4 * 128 * 128 + (size_t)row * 128;
            const float* sc = PIN(22) + i * 512 + gq * 128;
            const float* wo = PIN(20) + (size_t)i * DM * DM + (size_t)(gq * 128) * DM + n;
            float a = 0.f;
            for (int d = 0; d < 128; ++d) a += pw[d] * sc[d] * wo[(size_t)d * DM];
            W[W_CDOUT + (size_t)i * DM * DM + (size_t)n * DM + row] = f2h(a);
        }
        if (gtid < 2048) { const int i = (int)gtid >> 10, g = ((int)gtid >> 6) & 15, pp = (int)gtid & 63;
            ssm_build(SSMT + gtid * 36, PIN(9) + i * 1024, PIN(10) + i * 1024, PIN(11) + i * 16, PIN(12) + (size_t)i * 16384, PIN(13) + (size_t)i * 16384, g, pp); }
        for (size_t idx = gtid; idx < (size_t)2 * 4 * 128 * 128; idx += NT) {
            const int t = (int)(idx >> 7) & 127, s = (int)idx & 127;
            WS16[idx] = s <= t ? f2h(PIN(25)[idx]) : (u16)0;
        }
        const float* x = PIN(0);
        for (size_t idx = gtid; idx < (size_t)MTOK * DM / 8; idx += NT) {
            const f32x4 a = *(const f32x4*)(x + idx * 8), b = *(const f32x4*)(x + idx * 8 + 4);
            u32x4 w; w.x = pkh(a.x, a.y); w.y = pkh(a.z, a.w); w.z = pkh(b.x, b.y); w.w = pkh(b.z, b.w);
            *(u32x4*)(X + idx * 8) = w;
        }
        PROBE_END(7)
    }
    GSYNC();

    for (int l = 0; l < DEPTH; ++l) {
        const int li = l >> 1;
        for (int sub = 0; sub < 3; ++sub) {
            int rsel;
            if (sub != 1) {
                const int ls = l * 2 + (sub >> 1);
                { PHASE_PTRS pg8::Gemm g{X, W + W_GU + (size_t)ls * NGU * DM, MTOK, NGU, DM}; pg8::StaticOrder S; S.init(MTOK, NGU, G, bid);
                  pg8::EpiSwiGLU Ep{H};
#ifndef NO_GU
 { PROBE_BEGIN(1) pg8::gemm_phase<pg8::EpiSwiGLU>(lds, g, S, Ep, wave0); PROBE_END(1) }
#endif
 }
                GSYNC();
                rsel = 0;
            } else if ((l & 1) == 0) {
                { PHASE_PTRS pg8::Gemm g{X, W + W_ABIN + (size_t)li * AB_IN * DM, MTOK, AB_IN, DM}; pg8::StaticOrder S; S.init(MTOK, AB_IN, G, bid);
                  pg8::EpiInAB Ep{Qb, Kb, VT, U};
#ifndef NO_INAB
 { PROBE_BEGIN(1) pg8::gemm_phase<pg8::EpiInAB>(lds, g, S, Ep, wave0); PROBE_END(1) }
#endif
 }
                GSYNC();
                {
                PHASE_PTRS THREAD_VARS
                const float* c_re = PIN(14) + (size_t)li * 16384; const float* c_im = PIN(15) + (size_t)li * 16384;
                const float* dsk = PIN(16) + li * 256;
                LAS float* ublk = (LAS float*)(lds + wave * 8192);
                LAS u16* S16 = (LAS u16*)(lds + wave * 8192 + 1024);
                PROBE_BEGIN(2)
#ifndef NO_SSM1
                for (int tk = gw; tk < 16384; tk += NGW) {
                    const int c = tk & 31, g = (tk >> 5) & 15, b = tk >> 9;
                    if (c == 31) continue;
                    SsmP P; ssm_setup(P, SSMT + (size_t)((li * 16 + g) * 64 + lane) * 36);
                    float sr = 0.f, si = 0.f;
                    const size_t tok0 = (size_t)b * SEQ + c * 64;
                    for (int blk = 0; blk < 4; ++blk) {
                        LDS_WAIT();
                        ssm_load_u(U, tok0 + blk * 16, g, ublk, lane);
                        LDS_WAIT();
#pragma unroll
                        for (int t = 0; t < 16; ++t) ssm_step(P, ublk + t * 16, sr, si);
                    }
                    *(f32x2*)(E + ((size_t)((b * 16 + g) * 32 + c) * 64 + lane) * 2) = (f32x2){sr, si};
                }
#endif
#ifndef NO_ATTN
                {
                    const float* relb = PIN(8) + (size_t)li * 12 * 257;
                    __syncthreads();
                    for (int bt = bid; bt < 6144; bt += G) {
                        const int cp = ((bt & 15) + (bt >> 8)) & 15, bh = bt >> 4, h = bh % 12, b = bh / 12;
                        attn_block_task((LAS u16*)lds, Qb, Kb, VT, relb + h * 257, CAT, b, h, cp, wave, lane);
                    }
                }
#endif
                PROBE_END(2)
                GSYNC();
                PROBE_BEGIN(5)
#ifndef NO_SSM3
                for (int tk = gw; tk < 16384; tk += NGW) {
                    const int c = tk & 31, g = (tk >> 5) & 15, b = tk >> 9;
                    const int fr = lane & 15, fq = lane >> 4;
                    SsmP P; ssm_setup(P, SSMT + (size_t)((li * 16 + g) * 64 + lane) * 36);
                    half8 cB[4];
#pragma unroll
                    for (int ks = 0; ks < 4; ++ks) {
                        const float* src = (ks < 2 ? c_re : c_im) + (size_t)(g * 16 + fr) * 64 + (ks & 1) * 32 + fq * 8;
                        const f32x4 v0 = *(const f32x4*)src, v1 = *(const f32x4*)(src + 4); const float sg = ks < 2 ? 1.f : -1.f;
                        cB[ks][0] = (_Float16)(sg * v0.x); cB[ks][1] = (_Float16)(sg * v0.y); cB[ks][2] = (_Float16)(sg * v0.z); cB[ks][3] = (_Float16)(sg * v0.w);
                        cB[ks][4] = (_Float16)(sg * v1.x); cB[ks][5] = (_Float16)(sg * v1.y); cB[ks][6] = (_Float16)(sg * v1.z); cB[ks][7] = (_Float16)(sg * v1.w);
                    }
                    const float dk = dsk[g * 16 + fr];
                    float sr = 0.f, si = 0.f;
                    for (int c2 = 0; c2 < c; ++c2) {
                        const f32x2 e = *(const f32x2*)(E + ((size_t)((b * 16 + g) * 32 + c2) * 64 + lane) * 2);
                        const float nsr = P.a64r * sr - P.a64i * si + e.x, nsi = P.a64r * si + P.a64i * sr + e.y; sr = nsr; si = nsi;
                    }
                    const size_t tok0 = (size_t)b * SEQ + c * 64;
                    for (int blk = 0; blk < 4; ++blk) {
                        LDS_WAIT();
                        ssm_load_u(U, tok0 + blk * 16, g, ublk, lane);
                        LDS_WAIT();
#pragma unroll
                        for (int t = 0; t < 16; ++t) {
                            ssm_step(P, ublk + t * 16, sr, si);
                            S16[t * 136 + lane] = f2h(sr); S16[t * 136 + 64 + lane] = f2h(si);
                        }
                        LDS_WAIT();
                        f32x4 acc = {0.f, 0.f, 0.f, 0.f};
#pragma unroll
                        for (int ks = 0; ks < 4; ++ks) { const half8 a = *(const LAS half8*)(S16 + fr * 136 + ks * 32 + fq * 8); acc = __builtin_amdgcn_mfma_f32_16x16x32_f16(a, cB[ks], acc, 0, 0, 0); }
#pragma unroll
                        for (int j = 0; j < 4; ++j) { const int t = fq * 4 + j; const float y = acc[j] + dk * ublk[t * 16 + fr];
                            GB[(tok0 + blk * 16 + t) * 256 + g * 16 + fr] = f2h(gelu_tanh(y)); }
                    }
                }
#endif
                PROBE_END(5)
                }
                GSYNC();
                { PHASE_PTRS pg8::Gemm g{GB, W + W_GLU + (size_t)li * 256 * 256, MTOK, 256, 256}; pg8::StaticOrder S; S.init(MTOK, 256, G, bid);
                  pg8::EpiGLU Ep{GB, PIN(18) + li * 256, CAT};
#ifndef NO_GLU
 { PROBE_BEGIN(1) pg8::gemm_phase<pg8::EpiGLU>(lds, g, S, Ep, wave0); PROBE_END(1) }
#endif
 }
                GSYNC();
                rsel = 1;
            } else {
                { PHASE_PTRS pg8::Gemm g{X, W + W_CDIN + (size_t)li * CD_IN * DM, MTOK, CD_IN, DM}; pg8::StaticOrder S; S.init(MTOK, CD_IN, G, bid);
                  pg8::EpiInCD Ep{HCD};
#ifndef NO_INCD
 { PROBE_BEGIN(1) pg8::gemm_phase<pg8::EpiInCD>(lds, g, S, Ep, wave0); PROBE_END(1) }
#endif
 }
                GSYNC();
                {
                PROBE_BEGIN(6)
                PHASE_PTRS THREAD_VARS
                for (size_t idx = gtid; idx < (size_t)MTOK * 64; idx += NT) {
                    const size_t tok = idx >> 6; const int j = (int)idx & 63, t = (int)tok & 2047, w = 2 << (j >> 4);
                    const u16* px = HCD + tok * CD_IN + j * 8;
                    const half8 x0 = *(const half8*)px;
                    float a[8];
#pragma unroll
                    for (int e = 0; e < 8; ++e) a[e] = (float)x0[e];
                    const int n = t < w - 1 ? t : w - 1;
                    for (int s = 1; s <= n; ++s) { const half8 xs = *(const half8*)(px - (size_t)s * CD_IN);
#pragma unroll
                        for (int e = 0; e < 8; ++e) a[e] += (float)xs[e]; }
                    const float inv = 1.0f / (float)(n + 1);
                    u32x4 o; o.x = pkh(a[0] * inv - (float)x0[0], a[1] * inv - (float)x0[1]); o.y = pkh(a[2] * inv - (float)x0[2], a[3] * inv - (float)x0[3]);
                    o.z = pkh(a[4] * inv - (float)x0[4], a[5] * inv - (float)x0[5]); o.w = pkh(a[6] * inv - (float)x0[6], a[7] * inv - (float)x0[7]);
                    *(u32x4*)(CAT + tok * DM + j * 8) = o;
                }
#ifndef NO_SGU
                {
                    const float* lg = PIN(23) + li * 512; const float* lb = PIN(24) + li * 512; const float* bsp = PIN(26) + li * 512;
                    LAS u16* VTL = (LAS u16*)lds; LAS f32x2* stats = (LAS f32x2*)(lds + 40960);
                    const int fr = lane & 15, fq = lane >> 4;
                    for (int task = bid; task < 512; task += G) {
                        const size_t tok0 = (size_t)task * 128;
                        for (int i = 0; i < 16; ++i) {
                            const int tk = wave * 16 + i;
                            const half8 v = *(const half8*)(HCD + (tok0 + tk) * CD_IN + 1024 + lane * 8);
                            float s = 0.f;
#pragma unroll
                            for (int e = 0; e < 8; ++e) s += (float)v[e];
                            const float mean = wave_sum(s) * (1.0f / 512.0f); float q = 0.f;
#pragma unroll
                            for (int e = 0; e < 8; ++e) { const float d = (float)v[e] - mean; q += d * d; }
                            const float rstd = 1.0f / sqrtf(wave_sum(q) * (1.0f / 512.0f) + LN_EPS);
                            if (lane == 0) stats[tk] = (f32x2){mean, rstd};
                        }
                        __syncthreads();
                        for (int hh = 0; hh < 4; ++hh) {
                            for (int r = 0; r < 4; ++r) {
                                const int vt = tid + 512 * r, s = vt & 127, c8 = vt >> 7;
                                const half8 v = *(const half8*)(HCD + (tok0 + s) * CD_IN + 1024 + hh * 128 + c8 * 8);
                                const f32x2 st = stats[s];
                                const f32x4 g0 = *(const f32x4*)(lg + hh * 128 + c8 * 8), g1 = *(const f32x4*)(lg + hh * 128 + c8 * 8 + 4);
                                const f32x4 b0 = *(const f32x4*)(lb + hh * 128 + c8 * 8), b1 = *(const f32x4*)(lb + hh * 128 + c8 * 8 + 4);
#pragma unroll
                                for (int e = 0; e < 8; ++e) { const float gg = e < 4 ? g0[e & 3] : g1[e & 3], bb = e < 4 ? b0[e & 3] : b1[e & 3];
                                    VTL[(c8 * 8 + e) * 136 + s] = f2h(((float)v[e] - st.x) * st.y * gg + bb); }
                            }
                            __syncthreads();
                            half8 a[4];
#pragma unroll
                            for (int ks = 0; ks < 4; ++ks) a[ks] = *(const LAS half8*)(VTL + (16 * wave + fr) * 136 + 32 * ks + fq * 8);
                            const u16* wsb = WS16 + (size_t)(li * 4 + hh) * 128 * 128;
#pragma unroll
                            for (int tt = 0; tt < 8; ++tt) {
                                f32x4 acc = {0.f, 0.f, 0.f, 0.f};
#pragma unroll
                                for (int ks = 0; ks < 4; ++ks) if (32 * ks <= 16 * tt + 15) {
                                    const half8 bf = *(const half8*)(wsb + (size_t)(16 * tt + fr) * 128 + 32 * ks + fq * 8);
                                    acc = __builtin_amdgcn_mfma_f32_16x16x32_f16(a[ks], bf, acc, 0, 0, 0);
                                }
                                const size_t tok = tok0 + 16 * tt + fr; const float bs = bsp[hh * 128 + 16 * tt + fr];
                                const half4 uu = *(const half4*)(HCD + tok * CD_IN + 512 + hh * 128 + 16 * wave + fq * 4);
                                u32x2 o; o.x = pkh((float)uu.x * (acc.x + bs), (float)uu.y * (acc.y + bs)); o.y = pkh((float)uu.z * (acc.z + bs), (float)uu.w * (acc.w + bs));
                                *(u32x2*)(CAT + tok * DM + 512 + hh * 128 + 16 * wave + fq * 4) = o;
                            }
                            __syncthreads();
                        }
                    }
                }
#endif
                PROBE_END(6)
                }
                GSYNC();
                rsel = 2;
            }
            { PHASE_PTRS
              const int ls2 = l * 2 + (sub >> 1);
              const u16* rA = rsel == 0 ? H : CAT;
              const u16* rB = rsel == 0 ? W + W_D + (size_t)ls2 * DM * DFF : (rsel == 1 ? W + W_ABOUT + (size_t)li * DM * DM : W + W_CDOUT + (size_t)li * DM * DM);
              const pg8::Gemm gr{rA, rB, MTOK, DM, rsel == 0 ? DFF : DM}; const float rs = rsel == 0 ? 0.5f : 1.0f;
              pg8::StaticOrder S; S.init(MTOK, DM, G, bid); pg8::EpiResid Ep{X, Y, rs};
#ifndef NO_RESID
 { PROBE_BEGIN(1) pg8::gemm_phase<pg8::EpiResid>(lds, gr, S, Ep, wave0); PROBE_END(1) }
#endif
 }
            GSYNC();
            {
                PROBE_BEGIN(3)
                PHASE_PTRS THREAD_VARS
                const float* gam = PIN(1) + (size_t)(l * 3 + sub) * DM; const float* bet = PIN(2) + (size_t)(l * 3 + sub) * DM;
                const bool fin = (l == DEPTH - 1 && sub == 2);
                f32x4 gv[4], bv[4];
#pragma unroll
                for (int j = 0; j < 4; ++j) { gv[j] = *(const f32x4*)(gam + 4 * lane + 256 * j); bv[j] = *(const f32x4*)(bet + 4 * lane + 256 * j); }
                for (int row = gw; row < MTOK; row += NGW) {
                    float* yr = Y + (size_t)row * DM + 4 * lane;
                    f32x4 v[4]; float s = 0.f;
#pragma unroll
                    for (int j = 0; j < 4; ++j) { v[j] = *(const f32x4*)(yr + 256 * j); s += (v[j].x + v[j].y) + (v[j].z + v[j].w); }
                    const float mean = wave_sum(s) * (1.0f / DM); float q = 0.f;
#pragma unroll
                    for (int j = 0; j < 4; ++j) { v[j] = v[j] - mean; q += (v[j].x * v[j].x + v[j].y * v[j].y) + (v[j].z * v[j].z + v[j].w * v[j].w); }
                    const float rstd = 1.0f / sqrtf(wave_sum(q) * (1.0f / DM) + LN_EPS);
#pragma unroll
                    for (int j = 0; j < 4; ++j) {
                        f32x4 o = v[j] * rstd * gv[j] + bv[j];
                        if (PROBE_SEL != 0 && fin && gw == 0) { const unsigned K = tacc / 100u; const unsigned e0 = (unsigned)(row / NGW) * 1024u + 4u * lane + 256u * j;
                            o.x += e0 < K ? 0.0625f : 0.f; o.y += e0 + 1 < K ? 0.0625f : 0.f; o.z += e0 + 2 < K ? 0.0625f : 0.f; o.w += e0 + 3 < K ? 0.0625f : 0.f; }
                        if (fin) *(f32x4*)(yr + 256 * j) = o;
                        else { u32x2 w; w.x = pkh(o.x, o.y); w.y = pkh(o.z, o.w); *(u32x2*)(X + (size_t)row * DM + 4 * lane + 256 * j) = w; }
                    }
                }
                PROBE_END(3)
            }
            if (!(l == DEPTH - 1 && sub == 2)) GSYNC();
        }
    }
}

extern "C" void kernel_launch(void* const* d_in, const int* in_sizes, int n_in, void* d_out, int out_size, void* d_ws, size_t ws_size, hipStream_t stream) {
    static int grid_blocks = 0;
    if (grid_blocks == 0) {
        if (n_in != 27 || out_size != MTOK * DM || ws_size < WS_END) { fprintf(stderr, "kernel_launch: unexpected shapes (n_in %d, out %d, ws %zu)\n", n_in, out_size, ws_size); grid_blocks = -1; return; }
        int dev = 0, cus = 0, per_cu = 0;
        hipGetDevice(&dev);
        hipDeviceGetAttribute(&cus, hipDeviceAttributeMultiprocessorCount, dev);
        if (hipFuncSetAttribute((const void*)fwd_megakernel, hipFuncAttributeMaxDynamicSharedMemorySize, LDS_BYTES) != hipSuccess) { fprintf(stderr, "kernel_launch: hipFuncSetAttribute failed\n"); grid_blocks = -1; return; }
        hipOccupancyMaxActiveBlocksPerMultiprocessor(&per_cu, (const void*)fwd_megakernel, 512, LDS_BYTES);
        if (per_cu < 1) per_cu = 1;
        grid_blocks = cus * 1;
        (void)hipGetLastError();
    }
    if (grid_blocks < 0) return;
    Params p{};
    for (int i = 0; i < 27; ++i) p.in[i] = (const float*)d_in[i];
    p.out = (float*)d_out; p.ws = (unsigned char*)d_ws;
    void* args[] = {&p};
    hipError_t e = hipLaunchCooperativeKernel((const void*)fwd_megakernel, dim3(grid_blocks), dim3(512), args, LDS_BYTES, stream);
    if (e != hipSuccess) fprintf(stderr, "cooperative launch failed: %s (grid %d)\n", hipGetErrorString(e), grid_blocks);
}
```
